# Optimizing an MI355X kernel written in HIP

```python
import math, functools
import jax, jax.numpy as jnp
from jax import lax
import numpy as np

D_MODEL = 1024
BATCH = 8
SEQ = 2048
DEPTH = 2
DEC_BATCH = 128
DEC_SEQ = 1
PAST_LEN = 16384
PAGE_SIZE = 128

N_META = 16
M_INNER = D_MODEL
M_HEADDIM = 64
M_HEADS = M_INNER // M_HEADDIM
M_GROUPS = 4
M_HPG = M_HEADS // M_GROUPS
M_STATE = 128
M_CONV = 4
M_CONV_DIM = M_INNER + 2 * M_GROUPS * M_STATE
M_CHUNK = 128
H_KDIM = 128
H_HEADS = D_MODEL // H_KDIM
H_VDIM = 128
H_WIDTH = H_HEADS * H_KDIM
H_VWIDTH = H_HEADS * H_VDIM
H_CHUNK = 32
R_HEADS = 4
R_KDIM = D_MODEL // R_HEADS
R_VDIM = 2 * R_KDIM
R_QK = R_HEADS * R_KDIM
R_V = R_HEADS * R_VDIM
R_CHUNK = 128
ROPE_BASE = 10000.0
D_FF = ((8 * D_MODEL // 3 + 255) // 256) * 256
DN_ALPHA = (2 * DEPTH) ** 0.25
DN_BETA = (8 * DEPTH) ** -0.25
IN_SPLITS = (M_INNER, M_CONV_DIM, M_HEADS, H_WIDTH, H_WIDTH, H_VWIDTH, H_VWIDTH,
             R_QK, R_QK, R_V, R_V, 3 * D_MODEL)
IN_DIM = sum(IN_SPLITS)

kernel_name = "hybrid_ssd_hgrn2_retention_step"


def layer_norm(x, g, b, eps=1e-5):
    xf = x.astype(jnp.float32)
    mu = jnp.mean(xf, axis=-1, keepdims=True)
    var = jnp.mean(jnp.square(xf - mu), axis=-1, keepdims=True)
    return ((xf - mu) * lax.rsqrt(var + eps)).astype(x.dtype) * g + b


def rms_norm(x, eps=1e-6):
    xf = x.astype(jnp.float32)
    return (xf * lax.rsqrt(jnp.mean(jnp.square(xf), axis=-1, keepdims=True) + eps)).astype(x.dtype)


def causal_mask(t):
    return jnp.tril(jnp.ones((t, t), dtype=bool))


def run_chunks(step, state, xs, head_len, chunk):
    bsz, total = xs[0].shape[0], xs[0].shape[1]
    outs = []
    if head_len > 0:
        state, o = step(state, tuple(a[:, :head_len] for a in xs))
        outs.append(o)
    rest = tuple(a[:, head_len:] for a in xs)
    rest_len = total - head_len
    if rest_len <= chunk:
        state, o = step(state, rest)
        outs.append(o)
    else:
        n = rest_len // chunk
        blocks = tuple(jnp.moveaxis(a.reshape((bsz, n, chunk) + a.shape[2:]), 1, 0) for a in rest)
        state, o = lax.scan(step, state, blocks)
        outs.append(jnp.moveaxis(o, 0, 1).reshape((bsz, rest_len) + o.shape[3:]))
    y = outs[0] if len(outs) == 1 else jnp.concatenate(outs, axis=1)
    return state, y


def rotary(x, positions):
    half = x.shape[-1] // 2
    inv_freq = 1.0 / (ROPE_BASE ** jnp.linspace(0.0, 1.0, half, dtype=jnp.float32))
    ang = positions[:, None] * inv_freq[None, :]
    cos = jnp.cos(ang)[None, :, None, :]
    sin = jnp.sin(ang)[None, :, None, :]
    x1 = x[..., :half].astype(jnp.float32)
    x2 = x[..., half:].astype(jnp.float32)
    return jnp.concatenate([x1 * cos - x2 * sin, x2 * cos + x1 * sin], axis=-1).astype(x.dtype)


def ssd_step(A, state, inp):
    x, dt, Bm, Cm = inp
    T = x.shape[1]
    cum = jnp.cumsum(dt * A, axis=1)
    mask = causal_mask(T)[None, :, :, None, None]
    decay = jnp.exp(jnp.where(mask, cum[:, :, None] - cum[:, None, :], -jnp.inf))
    cb = jnp.einsum('btgn,bsgn->btsg', Cm, Bm)
    w = cb[..., None] * decay * dt[:, None]
    y = jnp.einsum('btsgh,bsghp->btghp', w, x)
    y = y + jnp.einsum('btgn,bghpn->btghp', Cm, state) * jnp.exp(cum)[..., None]
    tail = jnp.exp(cum[:, -1:] - cum) * dt
    new_state = state * jnp.exp(cum[:, -1])[..., None, None] + jnp.einsum('bsgh,bsghp,bsgn->bghpn', tail, x, Bm)
    return new_state.astype(state.dtype), y.astype(x.dtype)


def mamba_branch(z, xbc, dt_raw, conv_buf, ssm_state, p, head_len):
    b, L = xbc.shape[0], xbc.shape[1]
    xpad = jnp.concatenate([conv_buf, xbc], axis=1)
    acc = p['conv_b']
    for k in range(M_CONV):
        acc = acc + xpad[:, k:k + L] * p['conv_w'][k]
    new_buf = xpad[:, -(M_CONV - 1):]
    xbc = jax.nn.silu(acc)
    xs = xbc[..., :M_INNER].reshape(b, L, M_GROUPS, M_HPG, M_HEADDIM)
    Bm = xbc[..., M_INNER:M_INNER + M_GROUPS * M_STATE].reshape(b, L, M_GROUPS, M_STATE)
    Cm = xbc[..., M_INNER + M_GROUPS * M_STATE:].reshape(b, L, M_GROUPS, M_STATE)
    dt = jax.nn.softplus((dt_raw + p['dt_bias']).astype(jnp.float32)).reshape(b, L, M_GROUPS, M_HPG)
    A = -jnp.exp(p['a_log'].astype(jnp.float32)).reshape(M_GROUPS, M_HPG)
    state = ssm_state.reshape(b, M_GROUPS, M_HPG, M_HEADDIM, M_STATE)
    state, y = run_chunks(functools.partial(ssd_step, A), state, (xs, dt, Bm, Cm), head_len, M_CHUNK)
    y = y + p['d_skip'].reshape(M_GROUPS, M_HPG)[..., None] * xs
    y = y.reshape(b, L, M_INNER) * jax.nn.silu(z)
    y = rms_norm(y.reshape(b, L, M_GROUPS, M_INNER // M_GROUPS)).reshape(b, L, M_INNER) * p['m_norm_w']
    return y, new_buf, state.reshape(b, M_HEADS, M_HEADDIM, M_STATE)


def hgrn_step(state, inp):
    q, logf, k, v = inp
    T = q.shape[1]
    cum = jnp.cumsum(logf, axis=1)
    mask = causal_mask(T)[None, :, :, None, None]
    decay = jnp.exp(jnp.where(mask, cum[:, :, None] - cum[:, None, :], -jnp.inf))
    scores = jnp.einsum('bthk,bshk,btshk->btsh', q, k, decay)
    o = jnp.einsum('btsh,bshv->bthv', scores, v)
    o = o + jnp.einsum('bthk,bhkv->bthv', q * jnp.exp(cum), state)
    new_state = state * jnp.exp(cum[:, -1])[..., None] + jnp.einsum('bshk,bshv->bhkv', k * jnp.exp(cum[:, -1:] - cum), v)
    return new_state.astype(state.dtype), o.astype(q.dtype)


def hgrn_branch(q, f_raw, i_in, g, state, lb, p, head_len):
    b, L = q.shape[0], q.shape[1]
    q = q.reshape(b, L, H_HEADS, H_KDIM) * (H_KDIM ** -0.5)
    fz = f_raw.astype(jnp.float32).reshape(b, L, H_HEADS, H_KDIM)
    lbh = lb.astype(jnp.float32).reshape(H_HEADS, H_KDIM)
    logf = jnp.logaddexp(jnp.log(lbh), jnp.log1p(-lbh) + jax.nn.log_sigmoid(fz))
    k = ((1.0 - lbh) * jax.nn.sigmoid(-fz)).astype(q.dtype)
    v = i_in.reshape(b, L, H_HEADS, H_VDIM)
    state, o = run_chunks(hgrn_step, state, (q, logf, k, v), head_len, H_CHUNK)
    o = rms_norm(o).reshape(b, L, H_VWIDTH) * p['h_norm_w'] * jax.nn.sigmoid(g)
    return o, state


def ret_step(log_gamma, state, inp):
    q, k, v = inp
    T = q.shape[1]
    t = jnp.arange(T, dtype=jnp.float32)
    diff = (t[:, None] - t[None, :])[..., None] * log_gamma
    decay = jnp.exp(jnp.where(causal_mask(T)[..., None], diff, -jnp.inf))
    scores = jnp.einsum('bthk,bshk->bhts', q, k) * jnp.transpose(decay, (2, 0, 1))[None]
    o = jnp.einsum('bhts,bshv->bthv', scores, v)
    o = o + jnp.einsum('bthk,bhkv->bthv', q, state) * jnp.exp((t + 1.0)[:, None] * log_gamma)[None, :, :, None]
    k_dec = k * jnp.exp((T - 1.0 - t)[:, None] * log_gamma)[None, :, :, None]
    new_state = state * jnp.exp(T * log_gamma)[:, None, None] + jnp.einsum('bshk,bshv->bhkv', k_dec, v)
    return new_state.astype(state.dtype), o.astype(q.dtype)


def retention_branch(q, k, v, g, state, positions, head_len):
    b, L = q.shape[0], q.shape[1]
    q = rotary(q.reshape(b, L, R_HEADS, R_KDIM), positions)
    k = rotary(k.reshape(b, L, R_HEADS, R_KDIM), positions) * (R_KDIM ** -0.5)
    v = v.reshape(b, L, R_HEADS, R_VDIM)
    log_gamma = jnp.log(1.0 - jnp.exp2(-5.0 - jnp.arange(R_HEADS, dtype=jnp.float32)))
    state, o = run_chunks(functools.partial(ret_step, log_gamma), state, (q, k, v), head_len, R_CHUNK)
    o = rms_norm(o).reshape(b, L, R_V) * jax.nn.silu(g)
    return o, state


def trunk_layer(x, conv_buf, ssm_state, hgrn_state, ret_state, positions, head_len, lb, p):
    proj = x @ p['w_in']
    offsets = np.cumsum(IN_SPLITS)[:-1].tolist()
    (m_z, m_xbc, m_dt, h_q, h_f, h_i, h_g, r_q, r_k, r_v, r_g, gates) = jnp.split(proj, offsets, axis=-1)
    y_m, new_conv, new_ssm = mamba_branch(m_z, m_xbc, m_dt, conv_buf, ssm_state, p, head_len)
    y_h, new_hgrn = hgrn_branch(h_q, h_f, h_i, h_g, hgrn_state, lb, p, head_len)
    y_r, new_ret = retention_branch(r_q, r_k, r_v, r_g, ret_state, positions, head_len)
    g_m, g_h, g_r = jnp.split(jax.nn.sigmoid(gates), 3, axis=-1)
    mixed = g_m * (y_m @ p['w_br_m']) + g_h * (y_h @ p['w_br_h']) + g_r * (y_r @ p['w_br_r'])
    x = layer_norm(DN_ALPHA * x + mixed @ p['w_out'], p['ln1_g'], p['ln1_b'])
    hg, hu = jnp.split(x @ p['w_ffn_in'], 2, axis=-1)
    x = layer_norm(DN_ALPHA * x + (jax.nn.silu(hg) * hu) @ p['w_ffn_out'], p['ln2_g'], p['ln2_b'])
    return x, new_conv, new_ssm, new_hgrn, new_ret


def setup_inputs(seed: int = 0) -> dict:
    key = jax.random.key(seed)
    ks = jax.random.split(key, 32)

    def nrm(k, shape, scale=1.0):
        return jax.random.normal(k, shape, jnp.float32) * scale

    dt0 = jnp.exp(jax.random.uniform(ks[10], (DEPTH, M_HEADS), jnp.float32, math.log(1e-3), math.log(1e-1)))
    return {
        "x_prompt": nrm(ks[0], (BATCH, SEQ, D_MODEL)),
        "x_sample": nrm(ks[1], (DEC_BATCH, DEC_SEQ, D_MODEL)),
        "state_ssm": nrm(ks[2], (DEPTH, DEC_BATCH, M_HEADS, M_HEADDIM, M_STATE), 0.3),
        "state_conv": nrm(ks[3], (DEPTH, DEC_BATCH, M_CONV - 1, M_CONV_DIM)),
        "state_hgrn": nrm(ks[4], (DEPTH, DEC_BATCH, H_HEADS, H_KDIM, H_VDIM), 0.3),
        "state_ret": nrm(ks[5], (DEPTH, DEC_BATCH, R_HEADS, R_KDIM, R_VDIM), 0.3),
        "meta_tokens": nrm(ks[6], (N_META, D_MODEL)),
        "ln_in_g": 1.0 + nrm(ks[7], (D_MODEL,), 0.02),
        "ln_in_b": nrm(ks[8], (D_MODEL,), 0.02),
        "w_in": nrm(ks[9], (DEPTH, D_MODEL, IN_DIM), D_MODEL ** -0.5),
        "conv_w": nrm(ks[11], (DEPTH, M_CONV, M_CONV_DIM), M_CONV ** -0.5),
        "conv_b": nrm(ks[12], (DEPTH, M_CONV_DIM), 0.02),
        "dt_bias": dt0 + jnp.log(-jnp.expm1(-dt0)),
        "a_log": jnp.log(jax.random.uniform(ks[13], (DEPTH, M_HEADS), jnp.float32, 1.0, 16.0)),
        "d_skip": 1.0 + nrm(ks[14], (DEPTH, M_HEADS), 0.1),
        "m_norm_w": 1.0 + nrm(ks[15], (DEPTH, M_INNER), 0.02),
        "hgrn_lb_logits": nrm(ks[16], (DEPTH, H_WIDTH)),
        "h_norm_w": 1.0 + nrm(ks[17], (DEPTH, H_VWIDTH), 0.02),
        "w_br_m": nrm(ks[18], (DEPTH, M_INNER, D_MODEL), DN_BETA * M_INNER ** -0.5),
        "w_br_h": nrm(ks[19], (DEPTH, H_VWIDTH, D_MODEL), DN_BETA * H_VWIDTH ** -0.5),
        "w_br_r": nrm(ks[20], (DEPTH, R_V, D_MODEL), DN_BETA * R_V ** -0.5),
        "w_out": nrm(ks[21], (DEPTH, D_MODEL, D_MODEL), DN_BETA * D_MODEL ** -0.5),
        "ln1_g": 1.0 + nrm(ks[22], (DEPTH, D_MODEL), 0.02),
        "ln1_b": nrm(ks[23], (DEPTH, D_MODEL), 0.02),
        "w_ffn_in": nrm(ks[24], (DEPTH, D_MODEL, 2 * D_FF), DN_BETA * D_MODEL ** -0.5),
        "w_ffn_out": nrm(ks[25], (DEPTH, D_FF, D_MODEL), DN_BETA * D_FF ** -0.5),
        "ln2_g": 1.0 + nrm(ks[26], (DEPTH, D_MODEL), 0.02),
        "ln2_b": nrm(ks[27], (DEPTH, D_MODEL), 0.02),
    }


def reference(x_prompt, x_sample, state_ssm, state_conv, state_hgrn, state_ret, meta_tokens,
              ln_in_g, ln_in_b, w_in, conv_w, conv_b, dt_bias, a_log, d_skip, m_norm_w,
              hgrn_lb_logits, h_norm_w, w_br_m, w_br_h, w_br_r, w_out, ln1_g, ln1_b,
              w_ffn_in, w_ffn_out, ln2_g, ln2_b):
    bp, sp = x_prompt.shape[0], x_prompt.shape[1]
    dt_ = x_prompt.dtype
    lb_cum = jnp.cumsum(jax.nn.softmax(hgrn_lb_logits.astype(jnp.float32), axis=0), axis=0)
    lbs = lb_cum - lb_cum[0]

    xp = jnp.concatenate([jnp.broadcast_to(meta_tokens[None].astype(dt_), (bp, N_META, D_MODEL)), x_prompt], axis=1)
    xp = layer_norm(xp, ln_in_g, ln_in_b)
    pos_p = jnp.arange(N_META + sp, dtype=jnp.float32)
    xs = layer_norm(x_sample, ln_in_g, ln_in_b)
    pos_s = PAST_LEN + jnp.arange(x_sample.shape[1], dtype=jnp.float32)

    conv_p, ssm_p, hgrn_p, ret_p = [], [], [], []
    conv_s, ssm_s, hgrn_s, ret_s = [], [], [], []
    for l in range(DEPTH):
        p = dict(w_in=w_in[l], conv_w=conv_w[l], conv_b=conv_b[l], dt_bias=dt_bias[l], a_log=a_log[l],
                 d_skip=d_skip[l], m_norm_w=m_norm_w[l], h_norm_w=h_norm_w[l], w_br_m=w_br_m[l],
                 w_br_h=w_br_h[l], w_br_r=w_br_r[l], w_out=w_out[l], ln1_g=ln1_g[l], ln1_b=ln1_b[l],
                 w_ffn_in=w_ffn_in[l], w_ffn_out=w_ffn_out[l], ln2_g=ln2_g[l], ln2_b=ln2_b[l])
        xp, c, s, h, r = trunk_layer(
            xp,
            jnp.zeros((bp, M_CONV - 1, M_CONV_DIM), dt_),
            jnp.zeros((bp, M_HEADS, M_HEADDIM, M_STATE), dt_),
            jnp.zeros((bp, H_HEADS, H_KDIM, H_VDIM), dt_),
            jnp.zeros((bp, R_HEADS, R_KDIM, R_VDIM), dt_),
            pos_p, N_META, lbs[l], p)
        conv_p.append(c); ssm_p.append(s); hgrn_p.append(h); ret_p.append(r)
        xs, c, s, h, r = trunk_layer(xs, state_conv[l], state_ssm[l], state_hgrn[l], state_ret[l],
                                     pos_s, 0, lbs[l], p)
        conv_s.append(c); ssm_s.append(s); hgrn_s.append(h); ret_s.append(r)

    y_prompt = xp[:, N_META:]
    y_sample = xs
    return (y_prompt, y_sample,
            jnp.stack(ssm_p), jnp.stack(conv_p), jnp.stack(hgrn_p), jnp.stack(ret_p),
            jnp.stack(ssm_s), jnp.stack(conv_s), jnp.stack(hgrn_s), jnp.stack(ret_s))
```

```cpp
#ifndef EMU
#include <hip/hip_runtime.h>
#include <cstdio>
#include <cstdint>
#define DEV __device__ __forceinline__
#define HD __host__ __device__ __forceinline__
#else
#include "emu.h"
#endif

#ifndef CFG_BATCH
#define CFG_BATCH 8
#define CFG_SEQ 2048
#define CFG_DEC 128
#endif
constexpr int D = 1024, NB = CFG_BATCH, SEQ = CFG_SEQ, SB = CFG_DEC, DEPTH = 2, NMETA = 16, PAST = 16384;
constexpr int RP = NB * SEQ, ROW_META = RP, ROW_SMP = RP + NMETA, R_USED = RP + NMETA + SB, R = ((R_USED + 255) / 256) * 256;
constexpr int NCH = SEQ / 32;
constexpr int NCI = NB * NCH + 1;
constexpr int IN_DIM = 16400, PW = 16384, PWP = PW + 128, N1 = 16640;
constexpr int C_Z = 0, C_X = 1024, C_B = 2048, C_C = 2560, C_HQ = 3072, C_HF = 4096, C_HI = 5120, C_HG = 6144, C_RQ = 7168, C_RK = 8192, C_RV = 9216, C_RG = 11264, C_GATE = 13312;
constexpr int DFF = 2816;
constexpr float LN_EPS = 1e-5f, RMS_EPS = 1e-6f, DN_ALPHA = 1.41421356237f;
constexpr int ROPE_ROWS = SEQ + NMETA + 1;
constexpr size_t O_YP = 0, O_YS = O_YP + (size_t)RP * D, O_SSMP = O_YS + (size_t)SB * D, SZ_SSMP = (size_t)NB * 16 * 64 * 128, O_CONVP = O_SSMP + DEPTH * SZ_SSMP, SZ_CONVP = (size_t)NB * 3 * 2048,
    O_HGP = O_CONVP + DEPTH * SZ_CONVP, SZ_HGP = (size_t)NB * 8 * 128 * 128, O_RETP = O_HGP + DEPTH * SZ_HGP, SZ_RETP = (size_t)NB * 4 * 256 * 512,
    O_SSMS = O_RETP + DEPTH * SZ_RETP, SZ_SSMS = (size_t)SB * 16 * 64 * 128, O_CONVS = O_SSMS + DEPTH * SZ_SSMS, SZ_CONVS = (size_t)SB * 3 * 2048,
    O_HGS = O_CONVS + DEPTH * SZ_CONVS, SZ_HGS = (size_t)SB * 8 * 128 * 128, O_RETS = O_HGS + DEPTH * SZ_HGS, SZ_RETS = (size_t)SB * 4 * 256 * 512, O_END = O_RETS + DEPTH * SZ_RETS;

constexpr size_t al256(size_t x) { return (x + 255) & ~(size_t)255; }
constexpr size_t WS_CTL = 0, CTL_ZERO_BYTES = 1u << 20;
constexpr size_t SZ_W1T = (size_t)N1 * 1024 * 2, SZ_WSQ = (size_t)1024 * 1024 * 2, SZ_WRT = (size_t)1024 * 2048 * 2, SZ_WFIT = (size_t)2 * DFF * 1024 * 2, SZ_WFOT = (size_t)1024 * DFF * 2;
constexpr size_t WS_W1T = CTL_ZERO_BYTES, WS_WMT = WS_W1T + DEPTH * SZ_W1T, WS_WHT = WS_WMT + DEPTH * SZ_WSQ, WS_WRT = WS_WHT + DEPTH * SZ_WSQ, WS_WOT = WS_WRT + DEPTH * SZ_WRT,
    WS_WFIT = WS_WOT + DEPTH * SZ_WSQ, WS_WFOT = WS_WFIT + DEPTH * SZ_WFIT, WS_ROPE = WS_WFOT + DEPTH * SZ_WFOT, WS_LB = al256(WS_ROPE + (size_t)ROPE_ROWS * 256 * 4),
    WS_X = al256(WS_LB + DEPTH * 1024 * 4), WS_XPRE = WS_X + (size_t)R * D * 4, WS_XN = WS_XPRE + (size_t)R * D * 4, WS_PROJ = WS_XN + (size_t)R * D * 2, WS_DT = WS_PROJ + (size_t)R * PWP * 2,
    WS_YM = al256(WS_DT + (size_t)R * 16 * 4), WS_YH = WS_YM + (size_t)R * 1024 * 2, WS_YR = WS_YH + (size_t)R * 1024 * 2, WS_SSQM = WS_YR + (size_t)R * 2048 * 2, WS_SSQH = al256(WS_SSQM + (size_t)R * 8 * 4),
    WS_SSQR = al256(WS_SSQH + (size_t)R * 8 * 4), WS_MIX = al256(WS_SSQR + (size_t)R * 16 * 4), WS_MIXB = WS_MIX + (size_t)R * D * 4, WS_HB = WS_MIXB + (size_t)R * D * 2,
    WS_XC = al256(WS_HB + (size_t)R * DFF * 2), WS_BC = WS_XC + (size_t)R * 1024 * 2, WS_CC = WS_BC + (size_t)R * 512 * 2, WS_XW = WS_CC + (size_t)R * 512 * 2,
    WS_HDEC = WS_XW + (size_t)R * 1024 * 2, WS_ECUM = al256(WS_HDEC + (size_t)NCI * 8 * 128 * 4), WS_MDEC = al256(WS_ECUM + (size_t)NCI * 16 * 32 * 4), WS_END = al256(WS_MDEC + (size_t)NCI * 16 * 4);
constexpr int CW_TMO = 0, CW_CODE = 1, CW_QUEUE = 64  , CW_BAR = 4096;

typedef unsigned short bf16_t;
typedef short bf16x8 __attribute__((ext_vector_type(8)));
typedef short bf16x4 __attribute__((ext_vector_type(4)));
typedef float f32x4 __attribute__((ext_vector_type(4)));
typedef unsigned u32x4 __attribute__((ext_vector_type(4)));
typedef unsigned u32x2 __attribute__((ext_vector_type(2)));

#ifndef EMU
DEV int TID() { return threadIdx.x; }
DEV int TID_OPAQUE() { int t = threadIdx.x; asm volatile("" : "+v"(t)); return t; }
DEV int BID() { return blockIdx.x; }
DEV int NBLK() { return gridDim.x; }
DEV void block_sync() { __syncthreads(); }
DEV void lds_barrier() { asm volatile("s_waitcnt lgkmcnt(0)" ::: "memory"); __builtin_amdgcn_s_barrier(); asm volatile("" ::: "memory"); }
DEV void wave_sync() { asm volatile("s_waitcnt lgkmcnt(0)" ::: "memory"); }
DEV f32x4 mfma16(bf16x8 a, bf16x8 b, f32x4 c) { return __builtin_amdgcn_mfma_f32_16x16x32_bf16(a, b, c, 0, 0, 0); }
DEV float shflx(float v, int m) { return __shfl_xor(v, m); }
DEV int uniform(int v) { return __builtin_amdgcn_readfirstlane(v); }
DEV float fexp(float x) { return __expf(x); }
DEV float frcp(float x) { return __builtin_amdgcn_rcpf(x); }
typedef short s16x4_t __attribute__((ext_vector_type(4)));
DEV bf16x4 ds_tr4(const bf16_t* p) { return __builtin_amdgcn_ds_read_tr16_b64_v4i16((__attribute__((address_space(3))) s16x4_t*)p); }
DEV float flog(float x) { return __logf(x); }
DEV unsigned queue_pop(unsigned* p) { return __hip_atomic_fetch_add(p, 1u, __ATOMIC_RELAXED, __HIP_MEMORY_SCOPE_AGENT); }
typedef float f32x2_t __attribute__((ext_vector_type(2)));
typedef __bf16 bf16x2_t __attribute__((ext_vector_type(2)));
DEV unsigned pk2(float lo, float hi) { const f32x2_t v = {lo, hi}; return __builtin_bit_cast(unsigned, __builtin_convertvector(v, bf16x2_t)); }
#endif
DEV float u2f(unsigned u) { return __builtin_bit_cast(float, u); }
DEV unsigned f2u(float f) { return __builtin_bit_cast(unsigned, f); }
DEV float bf2f(bf16_t v) { return u2f((unsigned)v << 16); }
DEV bf16_t f2bf(float f) { return (bf16_t)(pk2(f, 0.f) & 0xffffu); }
DEV float sigm(float x) { return frcp(1.f + fexp(-x)); }
DEV float silu(float x) { return x * frcp(1.f + fexp(-x)); }
DEV float softplus(float x) { return x > 20.f ? x : flog(1.f + fexp(x)); }
DEV void unpack8(u32x4 w, float (&f)[8]) { f[0] = u2f(w.x << 16); f[1] = u2f(w.x & 0xffff0000u); f[2] = u2f(w.y << 16); f[3] = u2f(w.y & 0xffff0000u); f[4] = u2f(w.z << 16); f[5] = u2f(w.z & 0xffff0000u); f[6] = u2f(w.w << 16); f[7] = u2f(w.w & 0xffff0000u); }
DEV u32x4 pack8(const float (&f)[8]) { u32x4 w; w.x = pk2(f[0], f[1]); w.y = pk2(f[2], f[3]); w.z = pk2(f[4], f[5]); w.w = pk2(f[6], f[7]); return w; }
DEV bf16x8 pack8v(f32x4 a, f32x4 b) { u32x4 w; w.x = pk2(a[0], a[1]); w.y = pk2(a[2], a[3]); w.z = pk2(b[0], b[1]); w.w = pk2(b[2], b[3]); return __builtin_bit_cast(bf16x8, w); }
DEV u32x2 pk4(f32x4 v) { u32x2 w; w.x = pk2(v[0], v[1]); w.y = pk2(v[2], v[3]); return w; }
DEV float wave_sum(float v) {
#pragma unroll
    for (int o = 1; o < 64; o <<= 1) v += shflx(v, o);
    return v;
}
DEV bf16x8 frag(const bf16_t* tile, int ld, int row, int k0) { return *(const bf16x8*)(tile + row * ld + k0); }
DEV bf16x8 fragp(const bf16_t* tile, int ld, int row, int kbase, int quad) {
    const bf16x4 lo = *(const bf16x4*)(tile + row * ld + kbase + 4 * quad), hi = *(const bf16x4*)(tile + row * ld + kbase + 16 + 4 * quad);
    bf16x8 r; r[0] = lo[0]; r[1] = lo[1]; r[2] = lo[2]; r[3] = lo[3]; r[4] = hi[0]; r[5] = hi[1]; r[6] = hi[2]; r[7] = hi[3]; return r;
}
DEV bf16x8 trpair(const bf16_t* tile, int ld, int rowA, int rowB, int col0, int lane) {
    const int q = (lane & 15) >> 2, p = lane & 3; const bf16x4 lo = ds_tr4(tile + (rowA + q) * ld + col0 + 4 * p), hi = ds_tr4(tile + (rowB + q) * ld + col0 + 4 * p);
    bf16x8 r; r[0] = lo[0]; r[1] = lo[1]; r[2] = lo[2]; r[3] = lo[3]; r[4] = hi[0]; r[5] = hi[1]; r[6] = hi[2]; r[7] = hi[3]; return r;
}
DEV bf16x8 trn(const bf16_t* tile, int ld, int r0, int col0, int lane) { const int g = lane >> 4; return trpair(tile, ld, r0 + 8 * g, r0 + 8 * g + 4, col0, lane); }
DEV bf16x8 trp(const bf16_t* tile, int ld, int r0, int col0, int lane) { const int g = lane >> 4; return trpair(tile, ld, r0 + 4 * g, r0 + 16 + 4 * g, col0, lane); }
#ifndef EMU
DEV f32x4 ldnt(const float* p) { return __builtin_nontemporal_load((const f32x4*)p); }
DEV void stnt(float* p, f32x4 v) { __builtin_nontemporal_store(v, (f32x4*)p); }
#else
DEV f32x4 ldnt(const float* p) { return *(const f32x4*)p; }
DEV void stnt(float* p, f32x4 v) { *(f32x4*)p = v; }
#endif
namespace pg8 {
#ifndef EMU
#define PG8_LAS __attribute__((address_space(3)))
#else
#define PG8_LAS
#endif
typedef unsigned short bf16_t;
typedef short bf16x8 __attribute__((ext_vector_type(8)));
typedef float f32x4 __attribute__((ext_vector_type(4)));
typedef unsigned u32x4 __attribute__((ext_vector_type(4)));
constexpr int BM = 256, BK = 64, HALF = 128, HTB = HALF * BK * 2  , STAGE_BYTES = 8 * HTB, NXCD = 8, WGM = 8;
HD int lds_byte(int r, int c) { const int st = (r >> 4) * 2 + (c >> 5), rr = r & 15, cc = c & 31, ob = rr * 64 + cc * 2; return st * 1024 + (ob ^ (((ob >> 9) & 1) << 5)); }
HD void stage_rc(int b, int& R, int& C) { const int st = b / 1024, sb = b % 1024, swz = sb ^ (((sb >> 9) & 1) << 5); R = (st >> 1) * 16 + swz / 64; C = (st & 1) * 32 + (swz % 64) / 2; }
HD int perm32(int rho) { const int n = rho >> 4, i = rho & 15; return 8 * (i >> 2) + 4 * n + (i & 3); }
struct Unit { int pm, pn; };
struct Gemm { const bf16_t* A; const bf16_t* Bt; int M, N, K; };
struct StaticOrder {
    int nM, nN, nwg, G, c;
    HD void init(int M, int N, int G_, int c_) { nM = M / BM; nN = N / BM; nwg = nM * nN; G = G_; c = c_; }
    HD bool next(int i, Unit& u) const {
        const long L = (long)i * G + c; if (L >= nwg) return false;
        int wgid = (int)L; { const int q = nwg / NXCD, r = nwg % NXCD, xcd = wgid % NXCD, off = wgid / NXCD; wgid = (xcd < r ? xcd * (q + 1) : r * (q + 1) + (xcd - r) * q) + off; }
        const int nig = WGM * nN, gid = wgid / nig, fm = gid * WGM, gsz = (nM - fm) < WGM ? (nM - fm) : WGM;
        u.pm = fm + ((wgid % nig) % gsz); u.pn = (wgid % nig) / gsz; return true;
    }
    DEV void a_ready(const Unit&) const {}
    DEV void done(const Unit&) const {}
};
#ifndef EMU
template <class Epi, class Sched, bool ALIGN_EPI = false, bool SP2 = false>
__device__ __forceinline__ void gemm_phase(PG8_LAS unsigned char* lds, const Gemm g, const Sched& S, const Epi& E) {
    int tid_ = threadIdx.x; asm volatile("" : "+v"(tid_));
    const int tid = tid_, wid = __builtin_amdgcn_readfirstlane(tid >> 6), lane = tid & 63, wr = wid >> 2, wc = wid & 3, fr = lane & 15, fq = lane >> 4;
    const int K = g.K, nt = K / BK;
    unsigned voffA[2], voffB[2];
#pragma unroll
    for (int i = 0; i < 2; ++i) { int R, C; stage_rc(tid * 16 + i * 8192, R, C); const int Rb = Epi::PERM ? ((R & ~31) + perm32(R & 31)) : R;
        voffA[i] = (unsigned)(R * K + C) * 2u; voffB[i] = (unsigned)(Rb * K + C) * 2u; }
    const size_t kstep = (size_t)(BK * 2);
    const size_t hstep = (size_t)HALF * K * 2;
    const size_t tstep = 2 * hstep;
    const unsigned ldsw = (unsigned)wid * 1024u;
    const int aoff = lds_byte(wr * 64 + fr, fq * 8), boff = lds_byte(wc * 32 + fr, fq * 8);
#define PG8_SA(b, h) (((b) * 2 + (h)) * HTB)
#define PG8_SB(b, h) ((4 + (b) * 2 + (h)) * HTB)
#define PG8_STAGE(bufoff, gbase, voff) do { _Pragma("unroll") for (int _i = 0; _i < 2; ++_i) \
        __builtin_amdgcn_global_load_lds((const unsigned*)((const char*)(gbase) + (voff)[_i]), (PG8_LAS unsigned*)(lds + (bufoff) + ldsw + _i * 8192), 16, 0, 0); } while (0)
#define PG8_LDA(dst, b, h) do { _Pragma("unroll") for (int m = 0; m < 4; ++m) _Pragma("unroll") for (int k = 0; k < 2; ++k) dst[m][k] = *(const PG8_LAS bf16x8*)(lds + PG8_SA(b, h) + aoff + m * 2048 + k * 1024); } while (0)
#define PG8_LDB(dst, b, h) do { _Pragma("unroll") for (int n = 0; n < 2; ++n) _Pragma("unroll") for (int k = 0; k < 2; ++k) dst[n][k] = *(const PG8_LAS bf16x8*)(lds + PG8_SB(b, h) + boff + n * 2048 + k * 1024); } while (0)
#define PG8_MMA(ai, bj, At, Bt) do { __builtin_amdgcn_s_setprio(1); _Pragma("unroll") for (int m = 0; m < 4; ++m) _Pragma("unroll") for (int n = 0; n < 2; ++n) _Pragma("unroll") for (int k = 0; k < 2; ++k) \
        acc[ai][bj][m][n] = __builtin_amdgcn_mfma_f32_16x16x32_bf16(Bt[n][k], At[m][k], acc[ai][bj][m][n], 0, 0, 0); __builtin_amdgcn_s_setprio(0); } while (0)
#define PG8_WAIT_V(n) asm volatile("s_waitcnt vmcnt(" #n ")" ::: "memory")
#define PG8_WAIT_L(n) asm volatile("s_waitcnt lgkmcnt(" #n ")" ::: "memory")
#define PG8_BAR __builtin_amdgcn_s_barrier()
#define PG8_SCHED __builtin_amdgcn_sched_barrier(0)
    Unit cur, nxt; int ui = 0;
    if (!S.next(0, cur)) return;
    f32x4 acc[2][2][4][2];
#pragma unroll
    for (int a = 0; a < 2; ++a)
#pragma unroll
        for (int b = 0; b < 2; ++b)
#pragma unroll
            for (int m = 0; m < 4; ++m)
#pragma unroll
                for (int n = 0; n < 2; ++n) acc[a][b][m][n] = (f32x4){0.f, 0.f, 0.f, 0.f};
    bf16x8 At[4][2], B0[2][2], B1[2][2];
    const char* cA = (const char*)g.A + (size_t)cur.pm * tstep; const char* cB = (const char*)g.Bt + (size_t)cur.pn * tstep;
    S.a_ready(cur);
    if constexpr (SP2) {
        PG8_STAGE(PG8_SB(0, 0), cB, voffB); PG8_STAGE(PG8_SB(0, 1), cB + hstep, voffB); PG8_STAGE(PG8_SA(0, 0), cA, voffA); PG8_STAGE(PG8_SA(0, 1), cA + hstep, voffA);
        if (wr == 1) PG8_BAR;
        PG8_WAIT_V(2); PG8_BAR;
        PG8_STAGE(PG8_SB(1, 0), cB + kstep, voffB); PG8_STAGE(PG8_SA(1, 0), cA + kstep, voffA); PG8_STAGE(PG8_SB(1, 1), cB + hstep + kstep, voffB);
        PG8_WAIT_V(6); PG8_BAR;
    } else {
        PG8_STAGE(PG8_SB(0, 0), cB, voffB); PG8_STAGE(PG8_SA(0, 0), cA, voffA); PG8_STAGE(PG8_SB(0, 1), cB + hstep, voffB); PG8_STAGE(PG8_SA(0, 1), cA + hstep, voffA);
        if (wr == 1) PG8_BAR;
        PG8_WAIT_V(4); PG8_BAR;
        PG8_STAGE(PG8_SB(1, 0), cB + kstep, voffB); PG8_STAGE(PG8_SA(1, 0), cA + kstep, voffA); PG8_STAGE(PG8_SB(1, 1), cB + hstep + kstep, voffB);
        PG8_WAIT_V(6); PG8_BAR;
    }
    for (;;) {
        const bool has_next = S.next(ui + 1, nxt);
        const char* nA = has_next ? (const char*)g.A + (size_t)nxt.pm * tstep : cA; const char* nB = has_next ? (const char*)g.Bt + (size_t)nxt.pn * tstep : cB;
        for (int t = 0; t < nt; t += 2) {
            const bool last = (t == nt - 2);
            const char* a1 = cA + (size_t)(t + 1) * kstep;
            const char* a2 = last ? nA : cA + (size_t)(t + 2) * kstep; const char* b2 = last ? nB : cB + (size_t)(t + 2) * kstep;
            const char* a3 = a2 + kstep; const char* b3 = b2 + kstep;
            if (last && has_next) S.a_ready(nxt);
            if constexpr (SP2) {
            PG8_LDB(B0, 0, 0); PG8_LDB(B1, 0, 1); PG8_SCHED; PG8_LDA(At, 0, 0); PG8_STAGE(PG8_SA(1, 1), a1 + hstep, voffA);
            PG8_WAIT_V(8); PG8_WAIT_L(0); PG8_BAR; PG8_MMA(0, 0, At, B0); PG8_MMA(0, 1, At, B1); PG8_BAR; PG8_SCHED;
            PG8_LDA(At, 0, 1); PG8_STAGE(PG8_SB(0, 0), b2, voffB); PG8_STAGE(PG8_SB(0, 1), b2 + hstep, voffB); PG8_STAGE(PG8_SA(0, 0), a2, voffA);
            PG8_WAIT_V(8); PG8_WAIT_L(0); PG8_BAR; PG8_MMA(1, 0, At, B0); PG8_MMA(1, 1, At, B1); PG8_BAR; PG8_SCHED;
            PG8_LDB(B0, 1, 0); PG8_LDB(B1, 1, 1); PG8_SCHED; PG8_LDA(At, 1, 0); PG8_STAGE(PG8_SA(0, 1), a2 + hstep, voffA);
            PG8_WAIT_V(8); PG8_WAIT_L(0); PG8_BAR; PG8_MMA(0, 0, At, B0); PG8_MMA(0, 1, At, B1); PG8_BAR; PG8_SCHED;
            PG8_LDA(At, 1, 1); PG8_STAGE(PG8_SB(1, 0), b3, voffB); PG8_STAGE(PG8_SB(1, 1), b3 + hstep, voffB); PG8_STAGE(PG8_SA(1, 0), a3, voffA);
            PG8_WAIT_V(8); PG8_WAIT_L(0); PG8_BAR; PG8_MMA(1, 0, At, B0); PG8_MMA(1, 1, At, B1); PG8_BAR; PG8_SCHED;
            } else {
            PG8_LDB(B0, 0, 0); PG8_SCHED; PG8_LDA(At, 0, 0); PG8_STAGE(PG8_SA(1, 1), a1 + hstep, voffA);
            PG8_WAIT_L(8); PG8_BAR; PG8_WAIT_L(0); PG8_MMA(0, 0, At, B0); PG8_BAR; PG8_SCHED;
            PG8_LDB(B1, 0, 1); PG8_STAGE(PG8_SB(0, 0), b2, voffB);
            PG8_BAR; PG8_WAIT_L(0); PG8_MMA(0, 1, At, B1); PG8_BAR;
            PG8_LDA(At, 0, 1); PG8_STAGE(PG8_SA(0, 0), a2, voffA);
            PG8_BAR; PG8_WAIT_L(0); PG8_MMA(1, 0, At, B0); PG8_BAR; PG8_SCHED;
            PG8_STAGE(PG8_SB(0, 1), b2 + hstep, voffB);
            PG8_WAIT_V(6); PG8_BAR; PG8_MMA(1, 1, At, B1); PG8_BAR;
            PG8_LDB(B0, 1, 0); PG8_SCHED; PG8_LDA(At, 1, 0); PG8_STAGE(PG8_SA(0, 1), a2 + hstep, voffA);
            PG8_WAIT_L(8); PG8_BAR; PG8_WAIT_L(0); PG8_MMA(0, 0, At, B0); PG8_BAR; PG8_SCHED;
            PG8_LDB(B1, 1, 1); PG8_STAGE(PG8_SB(1, 0), b3, voffB);
            PG8_BAR; PG8_WAIT_L(0); PG8_MMA(0, 1, At, B1); PG8_BAR;
            PG8_LDA(At, 1, 1); PG8_STAGE(PG8_SA(1, 0), a3, voffA);
            PG8_BAR; PG8_WAIT_L(0); PG8_MMA(1, 0, At, B0); PG8_BAR; PG8_SCHED;
            PG8_STAGE(PG8_SB(1, 1), b3 + hstep, voffB);
            PG8_WAIT_V(6); PG8_BAR; PG8_MMA(1, 1, At, B1); PG8_BAR;
            }
        }
        if constexpr (ALIGN_EPI) { if (wr == 0) PG8_BAR; }
        if constexpr (!Epi::AFTER_DRAIN) { E(acc, cur, wr, wc, fr, fq); S.done(cur); }
        if (!has_next) break;
#pragma unroll
        for (int a = 0; a < 2; ++a)
#pragma unroll
            for (int b = 0; b < 2; ++b)
#pragma unroll
                for (int m = 0; m < 4; ++m)
#pragma unroll
                    for (int n = 0; n < 2; ++n) acc[a][b][m][n] = (f32x4){0.f, 0.f, 0.f, 0.f};
        cur = nxt; cA = nA; cB = nB; ++ui;
        if constexpr (ALIGN_EPI) { if (wr == 1) PG8_BAR; }
    }
    PG8_WAIT_V(0);
    if constexpr (!ALIGN_EPI) { if (wr == 0) PG8_BAR; }
    PG8_BAR;
    if constexpr (Epi::AFTER_DRAIN) { E.fused(acc, cur, wr, wc, fr, fq, lds, wid, lane); S.done(cur); }
#undef PG8_SA
#undef PG8_SB
#undef PG8_STAGE
#undef PG8_LDA
#undef PG8_LDB
#undef PG8_MMA
#undef PG8_WAIT_V
#undef PG8_WAIT_L
#undef PG8_BAR
#undef PG8_SCHED
}
#else
template <class Epi, class Sched, bool ALIGN_EPI = false, bool SP2 = false>
inline void gemm_phase(unsigned char*, const Gemm g, const Sched& S, const Epi& E) {
    const int tid = TID(), wid = tid >> 6, lane = tid & 63, wr = wid >> 2, wc = wid & 3, fr = lane & 15, fq = lane >> 4;
    const int K = g.K; Unit u;
    std::vector<float> fa((size_t)8 * K), fb((size_t)16 * K);
    for (int i = 0; S.next(i, u); ++i) {
        for (int ai = 0; ai < 2; ++ai) for (int m = 0; m < 4; ++m) { const int row = 256 * u.pm + 128 * ai + 64 * wr + 16 * m + fr; for (int k = 0; k < K; ++k) fa[(size_t)(ai * 4 + m) * K + k] = bf2f(g.A[(size_t)row * K + k]); }
        for (int bj = 0; bj < 2; ++bj) for (int n = 0; n < 2; ++n) for (int e = 0; e < 4; ++e) { const int col = 256 * u.pn + 128 * bj + 32 * wc + (Epi::PERM ? 8 * fq + 4 * n + e : 16 * n + 4 * fq + e);
            for (int k = 0; k < K; ++k) fb[(size_t)(bj * 8 + n * 4 + e) * K + k] = bf2f(g.Bt[(size_t)col * K + k]); }
        f32x4 acc[2][2][4][2];
        for (int ai = 0; ai < 2; ++ai) for (int bj = 0; bj < 2; ++bj) for (int m = 0; m < 4; ++m) for (int n = 0; n < 2; ++n) for (int e = 0; e < 4; ++e) {
            const float* pa = &fa[(size_t)(ai * 4 + m) * K]; const float* pb = &fb[(size_t)(bj * 8 + n * 4 + e) * K]; float s = 0.f; for (int k = 0; k < K; ++k) s += pa[k] * pb[k]; acc[ai][bj][m][n][e] = s; }
        E(acc, u, wr, wc, fr, fq);
    }
    block_sync();
}
#endif
}
#ifndef EMU
#define LAS __attribute__((address_space(3)))
#define XB_TMO      128
#define XB_XCNT(j)  (256  + 64 * (j))
#define XB_XSUB(j)  (1280 + 64 * (j))
#define XB_XGEN(j)  (2304 + 64 * (j))
#define XB_TOP      3328
#define XB_TOPGEN   3392
#define XCD_BAR_WORDS 3456
#define XB_SPIN_CAP (1u << 18)

__device__ __forceinline__ unsigned xb_ld(unsigned* p)              { return __hip_atomic_load(p, __ATOMIC_RELAXED, __HIP_MEMORY_SCOPE_AGENT); }
__device__ __forceinline__ unsigned xb_add(unsigned* p, unsigned v) { return __hip_atomic_fetch_add(p, v, __ATOMIC_RELAXED, __HIP_MEMORY_SCOPE_AGENT); }
__device__ __forceinline__ unsigned xb_xcc_id() { return (unsigned)__builtin_amdgcn_s_getreg((3 << 11) | 20) & 0xFu; }
#define XB_SPIN(cond, bar) do { unsigned _sp = 0; while (cond) { __builtin_amdgcn_s_sleep(1); \
    if ((++_sp & 255u) == 0u) { if (xb_ld(&(bar)[XB_TMO])) break; if (_sp > XB_SPIN_CAP) { atomicAdd(&(bar)[XB_TMO], 1u); break; } } } } while (0)

struct XcdBarrier {
    unsigned* bar; unsigned x;
    volatile LAS unsigned* st;
};

__device__ __forceinline__ XcdBarrier xcd_barrier_post(unsigned* bar, volatile LAS unsigned* st) {
    XcdBarrier b; b.bar = bar; b.x = xb_xcc_id(); b.st = st;
    if (threadIdx.x == 0) (void)xb_add(&bar[XB_XCNT(b.x)], 1u);
    return b;
}
__device__ __forceinline__ void xcd_barrier_complete(unsigned* bar, unsigned x, unsigned& nloc, unsigned& nx) {
    const unsigned G = gridDim.x * gridDim.y * gridDim.z;
    unsigned sum, cnt, mine, sp = 0u;
    for (;;) {
        sum = 0u; cnt = 0u; mine = 0u;
#pragma unroll
        for (unsigned j = 0; j < 16; ++j) { const unsigned c = xb_ld(&bar[XB_XCNT(j)]); sum += c; cnt += (c > 0u) ? 1u : 0u; mine = (j == x) ? c : mine; }
        if (sum == G) break;
        __builtin_amdgcn_s_sleep(1);
        if ((++sp & 255u) == 0u) { if (xb_ld(&bar[XB_TMO])) break; if (sp > XB_SPIN_CAP) { atomicAdd(&bar[XB_TMO], 1u); break; } }
    }
    nloc = mine > 0u ? mine : 1u; nx = cnt > 0u ? cnt : 1u;
}

__device__ __forceinline__ void xcd_barrier(const XcdBarrier& b) {
    asm volatile("s_waitcnt vmcnt(0)" ::: "memory");
    __syncthreads();
    if (threadIdx.x == 0) {
        unsigned* bar = b.bar;
        __builtin_amdgcn_s_waitcnt(0);
        unsigned nloc = b.st[0], nx = b.st[1];
        if (nloc == 0u) { xcd_barrier_complete(bar, b.x, nloc, nx); b.st[0] = nloc; b.st[1] = nx; }
        const unsigned old = xb_add(&bar[XB_XSUB(b.x)], 1u);
        const unsigned gen = old / nloc;
        if (old + 1u == (gen + 1u) * nloc) {
            __builtin_amdgcn_fence(__ATOMIC_RELEASE, "agent");
            asm volatile("s_waitcnt vmcnt(0)" ::: "memory");
            const unsigned og = xb_add(&bar[XB_TOP], 1u);
            const unsigned tg = og / nx;
            if (og + 1u == (tg + 1u) * nx) xb_add(&bar[XB_TOPGEN], 1u);
            else XB_SPIN(xb_ld(&bar[XB_TOPGEN]) == tg, bar);
            __builtin_amdgcn_fence(__ATOMIC_ACQUIRE, "agent");
            xb_add(&bar[XB_XGEN(b.x)], 1u);
            asm volatile("s_waitcnt vmcnt(0)" ::: "memory");
        } else {
            XB_SPIN(xb_ld(&bar[XB_XGEN(b.x)]) == gen, bar);
            __builtin_amdgcn_fence(__ATOMIC_ACQUIRE, "agent");
            asm volatile("s_waitcnt vmcnt(0)" ::: "memory");
        }
    }
    __syncthreads();
}
#endif
using pg8::Unit;
#ifndef EMU
#define EPI_FENCE() asm volatile("" ::: "memory")
#else
#define EPI_FENCE()
#endif
struct EpiProj {
    static constexpr bool PERM = true, AFTER_DRAIN = false;
    bf16_t* P; float* DT;
    DEV void operator()(const f32x4 (&acc)[2][2][4][2], const Unit& u, int wr, int wc, int fr, int fq) const {
        const int row0 = u.pm * 256 + wr * 64 + fr;
        if (u.pn < PW / 256) {
            const int col0 = u.pn * 256 + wc * 32 + 8 * fq;
#pragma unroll
            for (int ai = 0; ai < 2; ++ai)
#pragma unroll
                for (int m = 0; m < 4; ++m) { bf16_t* rowp = P + (size_t)(row0 + ai * 128 + m * 16) * PWP + col0;
#pragma unroll
                    for (int bj = 0; bj < 2; ++bj) { const f32x4 v0 = acc[ai][bj][m][0], v1 = acc[ai][bj][m][1]; u32x4 w; w.x = pk2(v0[0], v0[1]); w.y = pk2(v0[2], v0[3]); w.z = pk2(v1[0], v1[1]); w.w = pk2(v1[2], v1[3]);
                        *(u32x4*)(rowp + bj * 128) = w; } }
        } else if (wc == 0 && fq < 2) {
#pragma unroll
            for (int ai = 0; ai < 2; ++ai)
#pragma unroll
                for (int m = 0; m < 4; ++m) { float* rowp = DT + (size_t)(row0 + ai * 128 + m * 16) * 16 + 8 * fq; *(f32x4*)rowp = acc[ai][0][m][0]; *(f32x4*)(rowp + 4) = acc[ai][0][m][1]; }
        }
    }
};
template <int MODE> struct EpiBranch {
    static constexpr bool PERM = true, AFTER_DRAIN = false;
    const bf16_t* GATE; float* MIX; bf16_t* MIXB;
    DEV void operator()(const f32x4 (&acc)[2][2][4][2], const Unit& u, int wr, int wc, int fr, int fq) const {
        const int row0 = u.pm * 256 + wr * 64 + fr, col0 = u.pn * 256 + wc * 32 + 8 * fq;
#pragma unroll
        for (int ai = 0; ai < 2; ++ai)
#pragma unroll
            for (int m = 0; m < 4; ++m) { const size_t row = (size_t)(row0 + ai * 128 + m * 16);
#pragma unroll
                for (int bj = 0; bj < 2; ++bj) { const int c = col0 + bj * 128; float g[8]; unpack8(*(const u32x4*)(GATE + row * PWP + c), g);
                    f32x4 v0 = acc[ai][bj][m][0], v1 = acc[ai][bj][m][1];
#pragma unroll
                    for (int i = 0; i < 4; ++i) { v0[i] *= sigm(g[i]); v1[i] *= sigm(g[4 + i]); }
                    float* mp = MIX + row * D + c;
                    if (MODE >= 1) { v0 += *(const f32x4*)mp; v1 += *(const f32x4*)(mp + 4); }
                    if (MODE <= 1) { *(f32x4*)mp = v0; *(f32x4*)(mp + 4) = v1; }
                    else { u32x4 w; w.x = pk2(v0[0], v0[1]); w.y = pk2(v0[2], v0[3]); w.z = pk2(v1[0], v1[1]); w.w = pk2(v1[2], v1[3]); *(u32x4*)(MIXB + row * D + c) = w; } }
                EPI_FENCE(); }
    }
};
struct EpiResid {
    static constexpr bool PERM = true, AFTER_DRAIN = false;
    const float* XIN; float* OUT;
    DEV void operator()(const f32x4 (&acc)[2][2][4][2], const Unit& u, int wr, int wc, int fr, int fq) const {
        const int row0 = u.pm * 256 + wr * 64 + fr, col0 = u.pn * 256 + wc * 32 + 8 * fq;
#pragma unroll
        for (int ai = 0; ai < 2; ++ai)
#pragma unroll
            for (int m = 0; m < 4; ++m) { const size_t off = (size_t)(row0 + ai * 128 + m * 16) * D + col0;
#pragma unroll
                for (int bj = 0; bj < 2; ++bj) { const f32x4 x0 = *(const f32x4*)(XIN + off + bj * 128), x1 = *(const f32x4*)(XIN + off + bj * 128 + 4);
                    *(f32x4*)(OUT + off + bj * 128) = x0 * DN_ALPHA + acc[ai][bj][m][0]; *(f32x4*)(OUT + off + bj * 128 + 4) = x1 * DN_ALPHA + acc[ai][bj][m][1]; }
                EPI_FENCE(); }
    }
};
struct EpiSwiGLU {
    static constexpr bool PERM = true, AFTER_DRAIN = false;
    bf16_t* H;
    DEV void operator()(const f32x4 (&acc)[2][2][4][2], const Unit& u, int wr, int wc, int fr, int fq) const {
        const int row0 = u.pm * 256 + wr * 64 + fr, col0 = u.pn * 128 + wc * 32 + 8 * fq;
#pragma unroll
        for (int ai = 0; ai < 2; ++ai)
#pragma unroll
            for (int m = 0; m < 4; ++m) { const f32x4 g0 = acc[ai][0][m][0], g1 = acc[ai][0][m][1], u0 = acc[ai][1][m][0], u1 = acc[ai][1][m][1]; u32x4 w;
                w.x = pk2(silu(g0[0]) * u0[0], silu(g0[1]) * u0[1]); w.y = pk2(silu(g0[2]) * u0[2], silu(g0[3]) * u0[3]); w.z = pk2(silu(g1[0]) * u1[0], silu(g1[1]) * u1[1]); w.w = pk2(silu(g1[2]) * u1[2], silu(g1[3]) * u1[3]);
                *(u32x4*)(H + (size_t)(row0 + ai * 128 + m * 16) * DFF + col0) = w; }
    }
};

constexpr int NXR = NMETA + SB, NXB = (NXR + 15) / 16;
template <class F> DEV void skinny_gemm(const bf16_t* A, int K, int nunits, int vcu, int G, const F& f, unsigned char* lds) {
    constexpr int NPA = (NXR * 32 + 511) / 512;
    const int tid = TID_OPAQUE(), lane = tid & 63, w = uniform(tid >> 6), quad = lane >> 4, l15 = lane & 15;
    bf16_t* As = (bf16_t*)lds; bf16_t* Bs = (bf16_t*)(lds + NXR * 264 * 2);
    const bool own = 16 * w < NXR && w < 8, ext = NXB > 8 && w < 2;
    const int nkc = K / 256;
    for (int u = vcu; u < nunits; u += G) {
        f32x4 acc[4], acc8[2];
#pragma unroll
        for (int cb = 0; cb < 4; ++cb) acc[cb] = (f32x4){0.f, 0.f, 0.f, 0.f};
        acc8[0] = acc8[1] = (f32x4){0.f, 0.f, 0.f, 0.f};
        u32x4 ra[NPA], rb[4]; const bf16_t* pbs[4];
#pragma unroll
        for (int j = 0; j < 4; ++j) { const int id = tid + 512 * j, br = id >> 5; pbs[j] = f.brow(u, br >> 4) + (size_t)(br & 15) * K + 8 * (id & 31); }
#define SK_FETCH(kc) do { _Pragma("unroll") for (int j = 0; j < NPA; ++j) { const int id = tid + 512 * j, row = id >> 5; if (row < NXR) ra[j] = *(const u32x4*)(A + (size_t)row * K + 256 * (kc) + 8 * (id & 31)); } \
        _Pragma("unroll") for (int j = 0; j < 4; ++j) rb[j] = *(const u32x4*)(pbs[j] + 256 * (kc)); } while (0)
#define SK_STORE() do { _Pragma("unroll") for (int j = 0; j < NPA; ++j) { const int id = tid + 512 * j, row = id >> 5; if (row < NXR) *(u32x4*)(As + row * 264 + 8 * (id & 31)) = ra[j]; } \
        _Pragma("unroll") for (int j = 0; j < 4; ++j) { const int id = tid + 512 * j; *(u32x4*)(Bs + (id >> 5) * 264 + 8 * (id & 31)) = rb[j]; } } while (0)
        SK_FETCH(0); SK_STORE();
        lds_barrier();
        for (int kc = 0; kc < nkc; ++kc) {
            if (kc + 1 < nkc) SK_FETCH(kc + 1);
            if (own) {
#pragma unroll
                for (int kk = 0; kk < 8; ++kk) { const bf16x8 a = frag(As, 264, 16 * w + l15, 32 * kk + 8 * quad); bf16x8 bfr[4];
#pragma unroll
                    for (int cb = 0; cb < 4; ++cb) { bfr[cb] = frag(Bs, 264, 16 * cb + l15, 32 * kk + 8 * quad); acc[cb] = mfma16(bfr[cb], a, acc[cb]); }
                    if (ext) { const bf16x8 a8 = frag(As, 264, 128 + l15, 32 * kk + 8 * quad); acc8[0] = mfma16(w == 0 ? bfr[0] : bfr[1], a8, acc8[0]); acc8[1] = mfma16(w == 0 ? bfr[2] : bfr[3], a8, acc8[1]); } } }
            lds_barrier();
            if (kc + 1 < nkc) SK_STORE();
            lds_barrier();
        }
#undef SK_FETCH
#undef SK_STORE
        if (own && 16 * w + l15 < NXR) { f.epi(u, RP + 16 * w + l15, quad, 0, acc[0], acc[2]); f.epi(u, RP + 16 * w + l15, quad, 1, acc[1], acc[3]); }
        if (ext && 128 + l15 < NXR) f.epi(u, RP + 128 + l15, quad, w, acc8[0], acc8[1]);
    }
}
DEV void dt_gemm(const bf16_t* A, const bf16_t* Wdt, float* DT, int vcu, int G) {
    const int tid = TID_OPAQUE(), lane = tid & 63, w = uniform(tid >> 6), quad = lane >> 4, l15 = lane & 15;
    if (w >= 4) return;
    for (int u = vcu; u < RP / 64; u += G) { const int row = 64 * u + 16 * w + l15; const bf16_t* pa = A + (size_t)row * 1024 + 8 * quad; const bf16_t* pb = Wdt + (size_t)l15 * 1024 + 8 * quad; f32x4 acc = {0.f, 0.f, 0.f, 0.f};
#pragma unroll 8
        for (int kk = 0; kk < 32; ++kk) acc = mfma16(*(const bf16x8*)(pb + 32 * kk), *(const bf16x8*)(pa + 32 * kk), acc);
        *(f32x4*)(DT + (size_t)row * 16 + 4 * quad) = acc; }
}
struct SkProj {
    const bf16_t* W; bf16_t* P; float* DT;
    DEV const bf16_t* brow(int u, int cb) const { return W + (size_t)(u < 256 ? 64 * u + 16 * cb : PW) * 1024; }
    DEV void epi(int u, int row, int quad, int cb, f32x4 va, f32x4 vb) const {
        if (u < 256) { bf16_t* p = P + (size_t)row * PWP + 64 * u + 16 * cb + 4 * quad; *(u32x2*)p = pk4(va); *(u32x2*)(p + 32) = pk4(vb); }
        else if (cb == 0) *(f32x4*)(DT + (size_t)row * 16 + 4 * quad) = va; }
};
template <int MODE> struct SkBranch {
    const bf16_t* W; int K; const bf16_t* GATE; float* MIX; bf16_t* MIXB;
    DEV const bf16_t* brow(int u, int cb) const { return W + (size_t)(64 * u + 16 * cb) * K; }
    DEV void one(int row, int c, f32x4 v) const { const u32x2 gw = *(const u32x2*)(GATE + (size_t)row * PWP + c);
        v[0] *= sigm(u2f(gw.x << 16)); v[1] *= sigm(u2f(gw.x & 0xffff0000u)); v[2] *= sigm(u2f(gw.y << 16)); v[3] *= sigm(u2f(gw.y & 0xffff0000u));
        float* mp = MIX + (size_t)row * D + c; if (MODE >= 1) v += *(const f32x4*)mp; if (MODE <= 1) *(f32x4*)mp = v; else *(u32x2*)(MIXB + (size_t)row * D + c) = pk4(v); }
    DEV void epi(int u, int row, int quad, int cb, f32x4 va, f32x4 vb) const { one(row, 64 * u + 16 * cb + 4 * quad, va); one(row, 64 * u + 16 * cb + 32 + 4 * quad, vb); }
};
struct SkResid { const bf16_t* W; int K; const float* XIN; float* OUT;
    DEV const bf16_t* brow(int u, int cb) const { return W + (size_t)(64 * u + 16 * cb) * K; }
    DEV void epi(int u, int row, int quad, int cb, f32x4 va, f32x4 vb) const { const size_t o = (size_t)row * D + 64 * u + 16 * cb + 4 * quad;
        *(f32x4*)(OUT + o) = *(const f32x4*)(XIN + o) * DN_ALPHA + va; *(f32x4*)(OUT + o + 32) = *(const f32x4*)(XIN + o + 32) * DN_ALPHA + vb; }
};
struct SkSwiGLU { const bf16_t* W; bf16_t* H;
    DEV const bf16_t* brow(int u, int cb) const { const int oc = 32 * u + 16 * (cb & 1); return W + (size_t)(256 * (oc / 128) + (oc % 128) + 128 * (cb >> 1)) * 1024; }
    DEV void epi(int u, int row, int quad, int cb, f32x4 g, f32x4 uu) const { f32x4 o; o[0] = silu(g[0]) * uu[0]; o[1] = silu(g[1]) * uu[1]; o[2] = silu(g[2]) * uu[2]; o[3] = silu(g[3]) * uu[3];
        *(u32x2*)(H + (size_t)row * DFF + 32 * u + 16 * cb + 4 * quad) = pk4(o); }
};
struct Frame {
    unsigned char* lds; int tid, lane, wave, vcu, G;
    const float* const* in; float* out; unsigned char* ws; unsigned* ctl;
};
enum { I_XP = 0, I_XS, I_SSM, I_CONV, I_HGRN, I_RET, I_META, I_LNG, I_LNB, I_WIN, I_CONVW, I_CONVB, I_DTB, I_ALOG, I_DSKIP, I_MNW, I_LBL, I_HNW, I_WBM, I_WBH, I_WBR, I_WOUT, I_LN1G, I_LN1B, I_WFI, I_WFO, I_LN2G, I_LN2B };

DEV void transpose_item(const float* W, int Nsrc, int K, bf16_t* WT, int kb, int n0, int sc0, int nvalid, float* scr, int lane) {
    const int k0 = 64 * kb;
    float v[32];
#pragma unroll
    for (int i = 0; i < 32; ++i) { const int kk = 2 * i + (lane >> 5), nn = lane & 31; v[i] = nn < nvalid ? W[(size_t)(k0 + kk) * Nsrc + sc0 + nn] : 0.f; }
#pragma unroll
    for (int i = 0; i < 32; ++i) scr[(2 * i + (lane >> 5)) * 33 + (lane & 31)] = v[i];
    wave_sync();
    const int c = lane & 7;
#pragma unroll
    for (int j = 0; j < 4; ++j) { const int n = (lane >> 3) + 8 * j; const float* s = scr + (8 * c) * 33 + n;
        u32x4 o; o.x = pk2(s[0 * 33], s[1 * 33]); o.y = pk2(s[2 * 33], s[3 * 33]); o.z = pk2(s[4 * 33], s[5 * 33]); o.w = pk2(s[6 * 33], s[7 * 33]);
        *(u32x4*)(WT + (size_t)(n0 + n) * K + k0 + 8 * c) = o; }
    wave_sync();
}
DEV void ln_row(const float* src, const float* g, const float* b, float* dst32, bf16_t* dstbf, int lane) {
    f32x4 v[4]; float s = 0.f;
#pragma unroll
    for (int j = 0; j < 4; ++j) { v[j] = ((const f32x4*)src)[lane + 64 * j]; s += (v[j][0] + v[j][1]) + (v[j][2] + v[j][3]); }
    const float mean = wave_sum(s) * (1.f / D); float q = 0.f;
#pragma unroll
    for (int j = 0; j < 4; ++j) { v[j] = v[j] - mean; q += (v[j][0] * v[j][0] + v[j][1] * v[j][1]) + (v[j][2] * v[j][2] + v[j][3] * v[j][3]); }
    const float rstd = 1.f / sqrtf(wave_sum(q) * (1.f / D) + LN_EPS);
#pragma unroll
    for (int j = 0; j < 4; ++j) { const f32x4 gg = ((const f32x4*)g)[lane + 64 * j], bb = ((const f32x4*)b)[lane + 64 * j]; const f32x4 o = v[j] * rstd * gg + bb;
        if (dst32) ((f32x4*)dst32)[lane + 64 * j] = o;
        if (dstbf) { u32x2 w; w.x = pk2(o[0], o[1]); w.y = pk2(o[2], o[3]); ((u32x2*)dstbf)[lane + 64 * j] = w; } }
}
DEV void p0_prologue(const Frame& F) {
    float* scr = (float*)(F.lds + F.wave * 16384);
    const int gw = F.vcu * 8 + F.wave, NGW = F.G * 8;
    constexpr int I_W1 = 16 * (N1 / 32), I_SQ = 16 * 32, I_R = 32 * 32, I_FI = 16 * (2 * DFF / 32), I_FO = (DFF / 64) * 32, I_LAYER = I_W1 + 3 * I_SQ + I_R + I_FI + I_FO;
    for (int it = gw; it < DEPTH * I_LAYER; it += NGW) {
        const int l = it / I_LAYER; int r = it % I_LAYER;
        if (r < I_W1) { const int nb = r % (N1 / 32), kb = r / (N1 / 32), n0 = 32 * nb; int sc0 = n0, nv = 32; if (n0 >= 3072 && n0 < PW) sc0 = n0 + 16; else if (n0 == PW) { sc0 = 3072; nv = 16; } else if (n0 > PW) { sc0 = 0; nv = 0; }
            transpose_item(F.in[I_WIN] + (size_t)l * 1024 * IN_DIM, IN_DIM, 1024, (bf16_t*)(F.ws + WS_W1T + l * SZ_W1T), kb, n0, sc0, nv, scr, F.lane); continue; } r -= I_W1;
        if (r < I_SQ) { transpose_item(F.in[I_WBM] + (size_t)l * 1024 * 1024, 1024, 1024, (bf16_t*)(F.ws + WS_WMT + l * SZ_WSQ), r / 32, 32 * (r % 32), 32 * (r % 32), 32, scr, F.lane); continue; } r -= I_SQ;
        if (r < I_SQ) { transpose_item(F.in[I_WBH] + (size_t)l * 1024 * 1024, 1024, 1024, (bf16_t*)(F.ws + WS_WHT + l * SZ_WSQ), r / 32, 32 * (r % 32), 32 * (r % 32), 32, scr, F.lane); continue; } r -= I_SQ;
        if (r < I_R) { transpose_item(F.in[I_WBR] + (size_t)l * 2048 * 1024, 1024, 2048, (bf16_t*)(F.ws + WS_WRT + l * SZ_WRT), r / 32, 32 * (r % 32), 32 * (r % 32), 32, scr, F.lane); continue; } r -= I_R;
        if (r < I_SQ) { transpose_item(F.in[I_WOUT] + (size_t)l * 1024 * 1024, 1024, 1024, (bf16_t*)(F.ws + WS_WOT + l * SZ_WSQ), r / 32, 32 * (r % 32), 32 * (r % 32), 32, scr, F.lane); continue; } r -= I_SQ;
        if (r < I_FI) { const int nb = r % (2 * DFF / 32), kb = r / (2 * DFF / 32), n0 = 32 * nb, tile = n0 / 256, within = n0 % 256; const int sc0 = within < 128 ? 128 * tile + within : DFF + 128 * tile + (within - 128);
            transpose_item(F.in[I_WFI] + (size_t)l * 1024 * 2 * DFF, 2 * DFF, 1024, (bf16_t*)(F.ws + WS_WFIT + l * SZ_WFIT), kb, n0, sc0, 32, scr, F.lane); continue; } r -= I_FI;
        transpose_item(F.in[I_WFO] + (size_t)l * DFF * 1024, 1024, DFF, (bf16_t*)(F.ws + WS_WFOT + l * SZ_WFOT), r / 32, 32 * (r % 32), 32 * (r % 32), 32, scr, F.lane);
    }
    float* X = (float*)(F.ws + WS_X); bf16_t* XN = (bf16_t*)(F.ws + WS_XN);
    for (int r = gw; r < R; r += NGW) {
        if (r >= R_USED) { for (int j = 0; j < 4; ++j) { ((f32x4*)(X + (size_t)r * D))[F.lane + 64 * j] = (f32x4){0.f, 0.f, 0.f, 0.f}; ((u32x2*)(XN + (size_t)r * D))[F.lane + 64 * j] = (u32x2){0u, 0u}; } continue; }
        const float* src = r < RP ? F.in[I_XP] + (size_t)r * D : (r < ROW_SMP ? F.in[I_META] + (size_t)(r - ROW_META) * D : F.in[I_XS] + (size_t)(r - ROW_SMP) * D);
        ln_row(src, F.in[I_LNG], F.in[I_LNB], X + (size_t)r * D, XN + (size_t)r * D, F.lane);
    }
    float* rope = (float*)(F.ws + WS_ROPE);
    for (int i = F.vcu * 512 + F.tid; i < ROPE_ROWS * 128; i += F.G * 512) { const int p = i >> 7, f = i & 127; const float pos = (float)(p < SEQ + NMETA ? p : PAST);
        const float inv = 1.0f / powf(10000.0f, (float)f * (1.0f / 127.0f)); const float ang = pos * inv; rope[p * 256 + f] = cosf(ang); rope[p * 256 + 128 + f] = sinf(ang); }
    float* LB = (float*)(F.ws + WS_LB);
    for (int i = F.vcu * 512 + F.tid; i < 1024; i += F.G * 512) { LB[i] = 0.f; LB[1024 + i] = 1.f / (1.f + expf(F.in[I_LBL][i] - F.in[I_LBL][1024 + i])); }
}

DEV void ln_pass(const Frame& F, const float* g, const float* b, bool last) {
    const int gw = F.vcu * 8 + F.wave, NGW = F.G * 8; const float* XPRE = (const float*)(F.ws + WS_XPRE); float* X = (float*)(F.ws + WS_X); bf16_t* XN = (bf16_t*)(F.ws + WS_XN);
    for (int r = gw; r < R_USED; r += NGW) {
        if (!last) ln_row(XPRE + (size_t)r * D, g, b, X + (size_t)r * D, XN + (size_t)r * D, F.lane);
        else if (r < RP) ln_row(XPRE + (size_t)r * D, g, b, F.out + O_YP + (size_t)r * D, nullptr, F.lane);
        else if (r >= ROW_SMP) ln_row(XPRE + (size_t)r * D, g, b, F.out + O_YS + (size_t)(r - ROW_SMP) * D, nullptr, F.lane);
    }
}
struct Mix {
    unsigned char* ws; float* out; const float* const* in; int l;
    DEV bf16_t* PROJ() const { return (bf16_t*)(ws + WS_PROJ); }  DEV const float* DT() const { return (const float*)(ws + WS_DT); }
    DEV bf16_t* YM() const { return (bf16_t*)(ws + WS_YM); }  DEV bf16_t* YH() const { return (bf16_t*)(ws + WS_YH); }  DEV bf16_t* YR() const { return (bf16_t*)(ws + WS_YR); }
    DEV float* SSQM() const { return (float*)(ws + WS_SSQM); }  DEV float* SSQH() const { return (float*)(ws + WS_SSQH); }  DEV float* SSQR() const { return (float*)(ws + WS_SSQR); }
    DEV const float* rope() const { return (const float*)(ws + WS_ROPE); }  DEV const float* lb() const { return (const float*)(ws + WS_LB) + l * 1024; }
    DEV const float* conv_w() const { return in[I_CONVW] + (size_t)l * 4 * 2048; }  DEV const float* conv_b() const { return in[I_CONVB] + (size_t)l * 2048; }
    DEV const float* dt_bias() const { return in[I_DTB] + l * 16; }  DEV const float* a_log() const { return in[I_ALOG] + l * 16; }  DEV const float* d_skip() const { return in[I_DSKIP] + l * 16; }
    DEV const float* ssm_in() const { return in[I_SSM] + l * SZ_SSMS; }  DEV const float* conv_in() const { return in[I_CONV] + l * SZ_CONVS; }  DEV const float* hgrn_in() const { return in[I_HGRN] + l * SZ_HGS; }  DEV const float* ret_in() const { return in[I_RET] + l * SZ_RETS; }
    DEV float* ssm_p() const { return out + O_SSMP + l * SZ_SSMP; }  DEV float* conv_p() const { return out + O_CONVP + l * SZ_CONVP; }  DEV float* hgrn_p() const { return out + O_HGP + l * SZ_HGP; }  DEV float* ret_p() const { return out + O_RETP + l * SZ_RETP; }
    DEV float* ssm_s() const { return out + O_SSMS + l * SZ_SSMS; }  DEV float* conv_s() const { return out + O_CONVS + l * SZ_CONVS; }  DEV float* hgrn_s() const { return out + O_HGS + l * SZ_HGS; }  DEV float* ret_s() const { return out + O_RETS + l * SZ_RETS; }
    DEV bf16_t* XC() const { return (bf16_t*)(ws + WS_XC); }  DEV bf16_t* BC() const { return (bf16_t*)(ws + WS_BC); }  DEV bf16_t* CC() const { return (bf16_t*)(ws + WS_CC); }  DEV bf16_t* XW() const { return (bf16_t*)(ws + WS_XW); }
    DEV float* HDEC() const { return (float*)(ws + WS_HDEC); }  DEV float* ECUM() const { return (float*)(ws + WS_ECUM); }  DEV float* MDEC() const { return (float*)(ws + WS_MDEC); }
};
DEV void chunk_geo(int b, int c, int& row0, int& nv, int& pos0) { if (c == 0) { row0 = ROW_META; nv = NMETA; pos0 = 0; } else { row0 = b * SEQ + (c - 1) * 32; nv = 32; pos0 = NMETA + (c - 1) * 32; } }
DEV void ci_geo(int ci, int& b, int& row0, int& nv, int& pos0) { if (ci == NB * NCH) { b = 0; row0 = ROW_META; nv = NMETA; pos0 = 0; } else { b = ci / NCH; const int cc = ci % NCH; row0 = b * SEQ + cc * 32; nv = 32; pos0 = NMETA + cc * 32; } }
DEV int ci_of(int b, int c) { return c == 0 ? NB * NCH : b * NCH + (c - 1); }
DEV float log_gamma(int h) { return log1pf(-exp2f(-5.0f - (float)h)); }

struct RetRaw { u32x4 q1, q2, k1, k2, v[4]; f32x4 c0, c1, s0, s1; };
DEV void retA_fetch(const Mix& M, int h, int ci, int tid, RetRaw& r) {
    int b, row0, nv, pos0; ci_geo(ci, b, row0, nv, pos0); (void)b; const int srow = tid >> 4, sseg = tid & 15; const u32x4 z = {0u, 0u, 0u, 0u};
    r.q1 = r.q2 = r.k1 = r.k2 = z; r.c0 = r.c1 = r.s0 = r.s1 = (f32x4){0.f, 0.f, 0.f, 0.f};
    if (srow < nv) { const bf16_t* pr = M.PROJ() + (size_t)(row0 + srow) * PWP; const float* rp = M.rope() + (size_t)(pos0 + srow) * 256 + 8 * sseg;
        r.c0 = *(const f32x4*)rp; r.c1 = *(const f32x4*)(rp + 4); r.s0 = *(const f32x4*)(rp + 128); r.s1 = *(const f32x4*)(rp + 132);
        r.q1 = *(const u32x4*)(pr + C_RQ + 256 * h + 8 * sseg); r.q2 = *(const u32x4*)(pr + C_RQ + 256 * h + 128 + 8 * sseg); r.k1 = *(const u32x4*)(pr + C_RK + 256 * h + 8 * sseg); r.k2 = *(const u32x4*)(pr + C_RK + 256 * h + 128 + 8 * sseg); }
#pragma unroll
    for (int j = 0; j < 4; ++j) { const int id = tid + 512 * j, row = id >> 6, seg = id & 63; r.v[j] = row < nv ? *(const u32x4*)(M.PROJ() + (size_t)(row0 + row) * PWP + C_RV + 512 * h + 8 * seg) : z; }
}
DEV void retA_unit(const Mix& M, unsigned char* lds, int h, int ci, RetRaw& r, int ci_next) {
    const int tid = TID_OPAQUE(), lane = tid & 63, w = uniform(tid >> 6), quad = lane >> 4, l15 = lane & 15;
    bf16_t* Qn = (bf16_t*)(lds); bf16_t* Kd = (bf16_t*)(lds + 16896); bf16_t* Vn = (bf16_t*)(lds + 33792); bf16_t* Pl = (bf16_t*)(lds + 67072);
    int b, row0, nv, pos0; ci_geo(ci, b, row0, nv, pos0); (void)b; (void)pos0;
    const float lg = log_gamma(h); const int srow = tid >> 4, sseg = tid & 15;
    {   float q1[8], q2[8], k1[8], k2[8];
        if (srow < nv) { bf16_t* pr = M.PROJ() + (size_t)(row0 + srow) * PWP; float a1[8], a2[8]; const float kd = fexp((float)(nv - 1 - srow) * lg) * 0.0625f, qg = fexp((float)(srow + 1) * lg);
            const float cs[8] = {r.c0[0], r.c0[1], r.c0[2], r.c0[3], r.c1[0], r.c1[1], r.c1[2], r.c1[3]}, sn[8] = {r.s0[0], r.s0[1], r.s0[2], r.s0[3], r.s1[0], r.s1[1], r.s1[2], r.s1[3]};
            unpack8(r.q1, a1); unpack8(r.q2, a2);
#pragma unroll
            for (int i = 0; i < 8; ++i) { q1[i] = a1[i] * cs[i] - a2[i] * sn[i]; q2[i] = a2[i] * cs[i] + a1[i] * sn[i]; }
            unpack8(r.k1, a1); unpack8(r.k2, a2);
#pragma unroll
            for (int i = 0; i < 8; ++i) { k1[i] = (a1[i] * cs[i] - a2[i] * sn[i]) * kd; k2[i] = (a2[i] * cs[i] + a1[i] * sn[i]) * kd; }
            const u32x4 kp1 = pack8(k1), kp2 = pack8(k2);
            *(u32x4*)(Kd + srow * 264 + 8 * sseg) = kp1; *(u32x4*)(Kd + srow * 264 + 128 + 8 * sseg) = kp2;
            *(u32x4*)(pr + C_RK + 256 * h + 8 * sseg) = kp1; *(u32x4*)(pr + C_RK + 256 * h + 128 + 8 * sseg) = kp2;
            *(u32x4*)(Qn + srow * 264 + 8 * sseg) = pack8(q1); *(u32x4*)(Qn + srow * 264 + 128 + 8 * sseg) = pack8(q2);
#pragma unroll
            for (int i = 0; i < 8; ++i) { q1[i] *= qg; q2[i] *= qg; }
            *(u32x4*)(pr + C_RQ + 256 * h + 8 * sseg) = pack8(q1); *(u32x4*)(pr + C_RQ + 256 * h + 128 + 8 * sseg) = pack8(q2);
        } else { const u32x4 z = {0u, 0u, 0u, 0u}; *(u32x4*)(Kd + srow * 264 + 8 * sseg) = z; *(u32x4*)(Kd + srow * 264 + 128 + 8 * sseg) = z; *(u32x4*)(Qn + srow * 264 + 8 * sseg) = z; *(u32x4*)(Qn + srow * 264 + 128 + 8 * sseg) = z; }
#pragma unroll
        for (int j = 0; j < 4; ++j) { const int id = tid + 512 * j, row = id >> 6, seg = id & 63; *(u32x4*)(Vn + row * 520 + 8 * seg) = r.v[j]; }
    }
    if (ci_next >= 0) retA_fetch(M, h, ci_next, tid, r);
    lds_barrier();
    if (w < 3) { const int tb = w > 0, sb = w > 1; f32x4 P = {0.f, 0.f, 0.f, 0.f};
#pragma unroll
        for (int kk = 0; kk < 8; ++kk) P = mfma16(frag(Kd, 264, 16 * sb + l15, 32 * kk + 8 * quad), frag(Qn, 264, 16 * tb + l15, 32 * kk + 8 * quad), P);
        const int t = 16 * tb + l15; const float rs = fexp((float)(t + 1 - nv) * lg);
#pragma unroll
        for (int e = 0; e < 4; ++e) P[e] = (16 * sb + 4 * quad + e <= t) ? P[e] * rs : 0.f;
        *(u32x2*)(Pl + t * 40 + 16 * sb + 4 * quad) = pk4(P);
    } else if (w == 3) *(u32x2*)(Pl + l15 * 40 + 16 + 4 * quad) = (u32x2){0u, 0u};
    lds_barrier();
#pragma unroll
    for (int vb = 0; vb < 4; ++vb) { const int vc = 64 * w + 16 * vb; const bf16x8 a = trn(Vn, 520, 0, vc, lane);
#pragma unroll
        for (int tb = 0; tb < 2; ++tb) { const int t = 16 * tb + l15; const f32x4 O = mfma16(a, frag(Pl, 40, t, 8 * quad), (f32x4){0.f, 0.f, 0.f, 0.f});
            if (t < nv) *(u32x2*)(M.YR() + (size_t)(row0 + t) * 2048 + 512 * h + vc + 4 * quad) = pk4(O); } }
    lds_barrier();
}

struct HgRaw { u32x4 q, f, v; };
DEV void hgrnA_fetch(const Mix& M, int h, int ci, int tid, HgRaw& r) {
    int b, row0, nv, pos0; ci_geo(ci, b, row0, nv, pos0); (void)b; (void)pos0; const int srow = tid >> 4, sseg = tid & 15; const u32x4 z = {0u, 0u, 0u, 0u}; r.q = r.f = r.v = z;
    if (srow < nv) { const bf16_t* pr = M.PROJ() + (size_t)(row0 + srow) * PWP; r.q = *(const u32x4*)(pr + C_HQ + 128 * h + 8 * sseg); r.f = *(const u32x4*)(pr + C_HF + 128 * h + 8 * sseg); r.v = *(const u32x4*)(pr + C_HI + 128 * h + 8 * sseg); }
}
DEV void hgrnA_unit(const Mix& M, unsigned char* lds, int h, int ci, HgRaw& r, int ci_next) {
    const int tid = TID_OPAQUE(), lane = tid & 63, w = uniform(tid >> 6), quad = lane >> 4, l15 = lane & 15;
    float* CUM = (float*)lds; bf16_t* Qd = (bf16_t*)(lds + 16384); bf16_t* Kd = (bf16_t*)(lds + 25088); bf16_t* Vn = (bf16_t*)(lds + 33792); bf16_t* Pl = (bf16_t*)(lds + 42496);
    int b, row0, nv, pos0; ci_geo(ci, b, row0, nv, pos0); (void)b; (void)pos0;
    const int srow = tid >> 4, sseg = tid & 15;
    float q[8], kk8[8];
    {   float fz[8];
        if (srow < nv) { unpack8(r.q, q); unpack8(r.f, fz);
#pragma unroll
            for (int i = 0; i < 8; ++i) { const float lbv = M.lb()[128 * h + 8 * sseg + i], z = fz[i], ez = fexp(-fabsf(z)), ls = fminf(z, 0.f) - flog(1.f + ez);
                float lf = ls; if (lbv > 0.f) { const float a = flog(lbv), bb = flog(1.f - lbv) + ls; lf = fmaxf(a, bb) + flog(1.f + fexp(-fabsf(a - bb))); }
                const float sneg = (z >= 0.f ? ez : 1.f) * frcp(1.f + ez);
                CUM[srow * 128 + 8 * sseg + i] = lf; kk8[i] = (1.f - lbv) * sneg; q[i] *= 0.08838834764831845f; }
        } else {
#pragma unroll
            for (int i = 0; i < 8; ++i) { CUM[srow * 128 + 8 * sseg + i] = 0.f; q[i] = 0.f; kk8[i] = 0.f; } }
        *(u32x4*)(Vn + srow * 136 + 8 * sseg) = r.v;
    }
    if (ci_next >= 0) hgrnA_fetch(M, h, ci_next, tid, r);
    lds_barrier();
    if (tid < 128) { float v[32];
#pragma unroll
        for (int t = 0; t < 32; ++t) v[t] = CUM[t * 128 + tid];
        float a = 0.f;
#pragma unroll
        for (int t = 0; t < 32; ++t) { a += v[t]; CUM[t * 128 + tid] = a; } }
    lds_barrier();
    {   float qd[8], kd[8], qs[8], ks[8];
#pragma unroll
        for (int i = 0; i < 8; ++i) { const int ch = 8 * sseg + i; const float ct = CUM[srow * 128 + ch], cm = CUM[15 * 128 + ch], cl = CUM[31 * 128 + ch];
            qd[i] = q[i] * fexp(ct - cm); kd[i] = kk8[i] * fexp(cm - ct); qs[i] = q[i] * fexp(ct); ks[i] = kk8[i] * fexp(cl - ct);
            if (srow == 31) M.HDEC()[((size_t)ci * 8 + h) * 128 + ch] = fexp(cl); }
        *(u32x4*)(Qd + srow * 136 + 8 * sseg) = pack8(qd); *(u32x4*)(Kd + srow * 136 + 8 * sseg) = pack8(kd);
        if (srow < nv) { bf16_t* pr = M.PROJ() + (size_t)(row0 + srow) * PWP; *(u32x4*)(pr + C_HQ + 128 * h + 8 * sseg) = pack8(qs); *(u32x4*)(pr + C_HF + 128 * h + 8 * sseg) = pack8(ks); }
    }
    lds_barrier();
    if (w < 3) { const int tb = w > 0, sb = w > 1; f32x4 P = {0.f, 0.f, 0.f, 0.f};
#pragma unroll
        for (int kk = 0; kk < 4; ++kk) P = mfma16(frag(Kd, 136, 16 * sb + l15, 32 * kk + 8 * quad), frag(Qd, 136, 16 * tb + l15, 32 * kk + 8 * quad), P);
        const int t = 16 * tb + l15;
#pragma unroll
        for (int e = 0; e < 4; ++e) P[e] = (16 * sb + 4 * quad + e <= t) ? P[e] : 0.f;
        *(u32x2*)(Pl + t * 40 + 16 * sb + 4 * quad) = pk4(P);
    } else if (w == 3) *(u32x2*)(Pl + l15 * 40 + 16 + 4 * quad) = (u32x2){0u, 0u};
    lds_barrier();
    { const bf16x8 a = trn(Vn, 136, 0, 16 * w, lane);
#pragma unroll
      for (int tb = 0; tb < 2; ++tb) { const int t = 16 * tb + l15; const f32x4 O = mfma16(a, frag(Pl, 40, t, 8 * quad), (f32x4){0.f, 0.f, 0.f, 0.f});
          if (t < nv) *(u32x2*)(M.YH() + (size_t)(row0 + t) * 1024 + 128 * h + 16 * w + 4 * quad) = pk4(O); } }
    lds_barrier();
}

struct MbRaw { u32x4 x[5]; float dtr; };
DEV void mambaA_fetch(const Mix& M, int g, int ci, int tid, MbRaw& r) {
    int b, row0, nv, pos0; ci_geo(ci, b, row0, nv, pos0); const int seg = tid & 63;
    const int chan = seg < 32 ? 256 * g + 8 * seg : (seg < 48 ? 1024 + 128 * g + 8 * (seg - 32) : 1536 + 128 * g + 8 * (seg - 48));
#pragma unroll
    for (int j = 0; j < 5; ++j) { const int rr = (tid >> 6) + 8 * j, row = rr - 3, pos = pos0 + row; r.x[j] = (u32x4){0u, 0u, 0u, 0u};
        if (rr < 35 && pos >= 0 && row < nv) { const int gr = pos < NMETA ? ROW_META + pos : b * SEQ + pos - NMETA; r.x[j] = *(const u32x4*)(M.PROJ() + (size_t)gr * PWP + C_X + chan); } }
    r.dtr = 0.f; if (tid < 128 && (tid & 31) < nv) r.dtr = M.DT()[(size_t)(row0 + (tid & 31)) * 16 + 4 * g + (tid >> 5)];
}
DEV void mambaA_cw(const Mix& M, unsigned char* lds, int g) {
    float* CW = (float*)(lds + 36400); const int lc = TID_OPAQUE(); const int chn = lc < 256 ? 256 * g + lc : (lc < 384 ? 1024 + 128 * g + (lc - 256) : 1536 + 128 * g + (lc - 384));
#pragma unroll
    for (int k = 0; k < 4; ++k) CW[k * 512 + lc] = M.conv_w()[k * 2048 + chn];
    CW[4 * 512 + lc] = M.conv_b()[chn];
}
DEV void mambaA_unit(const Mix& M, unsigned char* lds, int g, int ci, MbRaw& r, int ci_next) {
    const int tid = TID_OPAQUE(), lane = tid & 63, w = uniform(tid >> 6), quad = lane >> 4, l15 = lane & 15;
    bf16_t* RAW = (bf16_t*)lds;
    float* CW = (float*)(lds + 36400);
    bf16_t* Xn = (bf16_t*)(lds + 46640); bf16_t* Bn = (bf16_t*)(lds + 63536); bf16_t* Cn = (bf16_t*)(lds + 72240);
    float* DTs = (float*)(lds + 80944); float* CUMs = (float*)(lds + 81456); float* CBl = (float*)(lds + 81968); bf16_t* Wl = (bf16_t*)(lds + 86576);
    int b, row0, nv, pos0; ci_geo(ci, b, row0, nv, pos0); (void)pos0;
    const bool lastc = ci != NB * NCH && (ci % NCH) == NCH - 1;
    const int seg = lane;
    const int chan = seg < 32 ? 256 * g + 8 * seg : (seg < 48 ? 1024 + 128 * g + 8 * (seg - 32) : 1536 + 128 * g + 8 * (seg - 48));
#pragma unroll
    for (int j = 0; j < 5; ++j) { const int rr = (tid >> 6) + 8 * j;
        if (rr < 35) { const int row = rr - 3; *(u32x4*)(RAW + rr * 520 + 8 * seg) = r.x[j];
            if (lastc && row >= 29) { float xv[8]; unpack8(r.x[j], xv); float* cp = M.conv_p() + ((size_t)b * 3 + (row - 29)) * 2048 + chan; *(f32x4*)cp = (f32x4){xv[0], xv[1], xv[2], xv[3]}; *(f32x4*)(cp + 4) = (f32x4){xv[4], xv[5], xv[6], xv[7]}; } } }
    if (tid < 128) { const int h4 = tid >> 5, row = tid & 31; float dtv = 0.f;
        if (row < nv) dtv = softplus(r.dtr + M.dt_bias()[4 * g + h4]);
        DTs[h4 * 32 + row] = dtv; CUMs[h4 * 32 + row] = -dtv * expf(M.a_log()[4 * g + h4]); }
    if (ci_next >= 0) mambaA_fetch(M, g, ci_next, tid, r);
    lds_barrier();
#pragma unroll 2
    for (int j = 0; j < 4; ++j) { const int row = (tid >> 6) + 8 * j; float o[8];
        { const f32x4 b0 = *(const f32x4*)(CW + 2048 + 8 * seg), b1 = *(const f32x4*)(CW + 2048 + 8 * seg + 4); o[0] = b0[0]; o[1] = b0[1]; o[2] = b0[2]; o[3] = b0[3]; o[4] = b1[0]; o[5] = b1[1]; o[6] = b1[2]; o[7] = b1[3]; }
#pragma unroll
        for (int k = 0; k < 4; ++k) { float xv[8]; unpack8(*(const u32x4*)(RAW + (row + k) * 520 + 8 * seg), xv); const f32x4 w0 = *(const f32x4*)(CW + k * 512 + 8 * seg), w1 = *(const f32x4*)(CW + k * 512 + 8 * seg + 4);
            o[0] += xv[0] * w0[0]; o[1] += xv[1] * w0[1]; o[2] += xv[2] * w0[2]; o[3] += xv[3] * w0[3]; o[4] += xv[4] * w1[0]; o[5] += xv[5] * w1[1]; o[6] += xv[6] * w1[2]; o[7] += xv[7] * w1[3]; }
#pragma unroll
        for (int i = 0; i < 8; ++i) o[i] = row < nv ? silu(o[i]) : 0.f;
        const u32x4 pk = pack8(o);
        if (seg < 32) { *(u32x4*)(Xn + row * 264 + 8 * seg) = pk; if (row < nv) *(u32x4*)(M.XC() + (size_t)(row0 + row) * 1024 + 256 * g + 8 * seg) = pk; }
        else if (seg < 48) { *(u32x4*)(Bn + row * 136 + 8 * (seg - 32)) = pk; if (row < nv) *(u32x4*)(M.BC() + (size_t)(row0 + row) * 512 + 128 * g + 8 * (seg - 32)) = pk; }
        else { *(u32x4*)(Cn + row * 136 + 8 * (seg - 48)) = pk; if (row < nv) *(u32x4*)(M.CC() + (size_t)(row0 + row) * 512 + 128 * g + 8 * (seg - 48)) = pk; }
    }
    if (tid < 4) { float v[32];
#pragma unroll
        for (int t = 0; t < 32; ++t) v[t] = CUMs[tid * 32 + t];
        float a = 0.f;
#pragma unroll
        for (int t = 0; t < 32; ++t) { a += v[t]; CUMs[tid * 32 + t] = a; } }
    lds_barrier();
    if (seg < 32) { const int h4 = seg >> 3;
#pragma unroll
        for (int j = 0; j < 4; ++j) { const int row = (tid >> 6) + 8 * j; const float ww = fexp(CUMs[h4 * 32 + 31] - CUMs[h4 * 32 + row]) * DTs[h4 * 32 + row];
            float xk[8]; unpack8(*(const u32x4*)(Xn + row * 264 + 8 * seg), xk);
#pragma unroll
            for (int i = 0; i < 8; ++i) xk[i] *= ww;
            if (row < nv) *(u32x4*)(M.XW() + (size_t)(row0 + row) * 1024 + 256 * g + 8 * seg) = pack8(xk); } }
    if (tid < 128) M.ECUM()[((size_t)ci * 16 + 4 * g) * 32 + tid] = fexp(CUMs[tid]);
    if (tid < 4) M.MDEC()[(size_t)ci * 16 + 4 * g + tid] = fexp(CUMs[tid * 32 + 31]);
    if (w < 3) { const int tb = w > 0, sb = w > 1; f32x4 P = {0.f, 0.f, 0.f, 0.f};
#pragma unroll
        for (int kk = 0; kk < 4; ++kk) P = mfma16(frag(Bn, 136, 16 * sb + l15, 32 * kk + 8 * quad), frag(Cn, 136, 16 * tb + l15, 32 * kk + 8 * quad), P);
        *(f32x4*)(CBl + (16 * tb + l15) * 36 + 16 * sb + 4 * quad) = P;
    } else if (w == 3) *(f32x4*)(CBl + l15 * 36 + 16 + 4 * quad) = (f32x4){0.f, 0.f, 0.f, 0.f};
    lds_barrier();
    { const int h4 = tid >> 7, t = (tid & 127) >> 2, s0 = 8 * (tid & 3); float wv[8]; const float ct = CUMs[h4 * 32 + t];
#pragma unroll
      for (int i = 0; i < 8; ++i) { const int s = s0 + i; wv[i] = s <= t ? CBl[t * 36 + s] * fexp(ct - CUMs[h4 * 32 + s]) * DTs[h4 * 32 + s] : 0.f; }
      *(u32x4*)(Wl + h4 * 1280 + t * 40 + s0) = pack8(wv); }
    lds_barrier();
    { const int hh = w >> 1, pc0 = 64 * hh + 32 * (w & 1);
#pragma unroll
      for (int pb = 0; pb < 2; ++pb) { const bf16x8 a = trn(Xn, 264, 0, pc0 + 16 * pb, lane);
#pragma unroll
          for (int tb = 0; tb < 2; ++tb) { const int t = 16 * tb + l15; const f32x4 Y = mfma16(a, frag(Wl + hh * 1280, 40, t, 8 * quad), (f32x4){0.f, 0.f, 0.f, 0.f});
              if (t < nv) *(u32x2*)(M.YM() + (size_t)(row0 + t) * 1024 + 256 * g + pc0 + 16 * pb + 4 * quad) = pk4(Y); } } }
    lds_barrier();
}

template <int MODE> DEV void scan_unit(const Mix& M, unsigned char* lds, int b, int hd, int vs) {
    constexpr int KD = MODE == 0 ? 256 : 128, VW = 128, PQ = KD + 8, PK = KD + 16, PV = VW + 16, PO = VW + 8, NKB = KD / 16, NPB = VW / 128, NQ = KD / 128, NV = VW / 128;
    constexpr int SZQ = 32 * PQ * 2, SZK = 32 * PK * 2, SZV = 32 * PV * 2, SZO = 32 * PO * 2, OFF_Q = 0, OFF_K = 2 * SZQ, OFF_V = OFF_K + 2 * SZK, OFF_O = OFF_V + 2 * SZV, OFF_D = OFF_O + SZO;
    const int tid = TID_OPAQUE(), lane = tid & 63, w = uniform(tid >> 6), quad = lane >> 4, l15 = lane & 15;
    float* DECl = (float*)(lds + OFF_D); float* RSl = DECl + 512; bf16_t* OT = (bf16_t*)(lds + OFF_O);
    const bf16_t* gQ = MODE == 0 ? M.PROJ() + C_RQ + 256 * hd : MODE == 1 ? M.PROJ() + C_HQ + 128 * hd : M.CC() + 128 * hd; const int ldQ = MODE == 2 ? 512 : PWP;
    const bf16_t* gK = MODE == 0 ? M.PROJ() + C_RK + 256 * hd : MODE == 1 ? M.PROJ() + C_HF + 128 * hd : M.BC() + 128 * hd; const int ldK = MODE == 2 ? 512 : PWP;
    const bf16_t* gV = MODE == 0 ? M.PROJ() + C_RV + 512 * hd + 128 * vs : MODE == 1 ? M.PROJ() + C_HI + 128 * hd : M.XW() + 256 * hd + 128 * vs; const int ldV = MODE == 2 ? 1024 : PWP;
    bf16_t* gY = MODE == 0 ? M.YR() + 512 * hd + 128 * vs : MODE == 1 ? M.YH() + 128 * hd : M.YM() + 256 * hd + 128 * vs; const int ldY = MODE == 0 ? 2048 : 1024;
    const float lg = log_gamma(hd);
    const int hh = 2 * vs + (w >> 2);
    const int v0 = 16 * w;
    f32x4 S[NPB][NKB];
#pragma unroll
    for (int i = 0; i < NPB; ++i)
#pragma unroll
        for (int j = 0; j < NKB; ++j) S[i][j] = (f32x4){0.f, 0.f, 0.f, 0.f};
    u32x4 rq[NQ], rk[NQ], rv[NV], ro[NV]; f32x4 rd = {0.f, 0.f, 0.f, 0.f};
    const u32x4 zero4 = {0u, 0u, 0u, 0u};
#define SCAN_FETCH(cn) do { int row0_, nv_, pos0_; chunk_geo(b, (cn), row0_, nv_, pos0_); (void)pos0_; const int ci_ = ci_of(b, (cn)); \
        _Pragma("unroll") for (int j = 0; j < NQ; ++j) { const int id = tid + 512 * j, row = id / (KD / 8), sg = id % (KD / 8); const bool ok = row < nv_; \
            rq[j] = ok ? *(const u32x4*)(gQ + (size_t)(row0_ + row) * ldQ + 8 * sg) : zero4; rk[j] = ok ? *(const u32x4*)(gK + (size_t)(row0_ + row) * ldK + 8 * sg) : zero4; } \
        _Pragma("unroll") for (int j = 0; j < NV; ++j) { const int id = tid + 512 * j, row = id / (VW / 8), sg = id % (VW / 8); const bool ok = row < nv_; \
            rv[j] = ok ? *(const u32x4*)(gV + (size_t)(row0_ + row) * ldV + 8 * sg) : zero4; ro[j] = ok ? *(const u32x4*)(gY + (size_t)(row0_ + row) * ldY + 8 * sg) : zero4; } \
        if (MODE == 1) { if (tid < 32) rd = *(const f32x4*)(M.HDEC() + ((size_t)ci_ * 8 + hd) * 128 + 4 * tid); } \
        if (MODE == 2) { if (tid < 32) rd = *(const f32x4*)(M.ECUM() + ((size_t)ci_ * 16 + 4 * hd) * 32 + 4 * tid); else if (tid == 32) rd = *(const f32x4*)(M.MDEC() + (size_t)ci_ * 16 + 4 * hd); } } while (0)
#define SCAN_STORE(d) do { \
        _Pragma("unroll") for (int j = 0; j < NQ; ++j) { const int id = tid + 512 * j, row = id / (KD / 8), sg = id % (KD / 8); \
            *(u32x4*)(lds + OFF_Q + (d) * SZQ + (row * PQ + 8 * sg) * 2) = rq[j]; *(u32x4*)(lds + OFF_K + (d) * SZK + (row * PK + 8 * sg) * 2) = rk[j]; } \
        _Pragma("unroll") for (int j = 0; j < NV; ++j) { const int id = tid + 512 * j, row = id / (VW / 8), sg = id % (VW / 8); \
            *(u32x4*)(lds + OFF_V + (d) * SZV + (row * PV + 8 * sg) * 2) = rv[j]; *(u32x4*)(OT + row * PO + 8 * sg) = ro[j]; } \
        if (MODE == 1) { if (tid < 32) *(f32x4*)(DECl + (d) * 256 + 4 * tid) = rd; } \
        if (MODE == 2) { if (tid < 32) *(f32x4*)(RSl + (d) * 128 + 4 * tid) = rd; else if (tid == 32) *(f32x4*)(DECl + (d) * 256) = rd; } } while (0)
    SCAN_FETCH(0); SCAN_STORE(0);
    block_sync();
    for (int c = 0; c <= NCH; ++c) {
        const int d = c & 1; int row0, nv, pos0; chunk_geo(b, c, row0, nv, pos0); (void)pos0;
        if (c < NCH) SCAN_FETCH(c + 1);
        const bf16_t* Qp = (const bf16_t*)(lds + OFF_Q + d * SZQ); const bf16_t* Kp = (const bf16_t*)(lds + OFF_K + d * SZK); const bf16_t* Vp = (const bf16_t*)(lds + OFF_V + d * SZV);
#pragma unroll
        for (int pb = 0; pb < NPB; ++pb) { const int vc = v0 + 16 * pb;
            f32x4 O0 = {0.f, 0.f, 0.f, 0.f}, O1 = O0;
#pragma unroll
            for (int kk = 0; kk < KD / 32; ++kk) { const bf16x8 sf = pack8v(S[pb][2 * kk], S[pb][2 * kk + 1]);
                O0 = mfma16(sf, fragp(Qp, PQ, l15, 32 * kk, quad), O0); O1 = mfma16(sf, fragp(Qp, PQ, 16 + l15, 32 * kk, quad), O1); }
            if (MODE == 2) { O0 *= RSl[d * 128 + hh * 32 + l15]; O1 *= RSl[d * 128 + hh * 32 + 16 + l15]; }
            { bf16_t* o0 = OT + l15 * PO + vc + 4 * quad; bf16_t* o1 = OT + (16 + l15) * PO + vc + 4 * quad; const u32x2 i0 = *(const u32x2*)o0, i1 = *(const u32x2*)o1;
              O0 += (f32x4){u2f(i0.x << 16), u2f(i0.x & 0xffff0000u), u2f(i0.y << 16), u2f(i0.y & 0xffff0000u)}; O1 += (f32x4){u2f(i1.x << 16), u2f(i1.x & 0xffff0000u), u2f(i1.y << 16), u2f(i1.y & 0xffff0000u)};
              *(u32x2*)o0 = pk4(O0); *(u32x2*)o1 = pk4(O1); }
            const bf16x8 vfn = trn(Vp, PV, 0, vc, lane);
            const float decs = MODE == 0 ? fexp((float)nv * lg) : MODE == 2 ? DECl[d * 256 + hh] : 0.f;
#pragma unroll
            for (int kb = 0; kb < NKB; ++kb) { f32x4 dv = {decs, decs, decs, decs}; if (MODE == 1) dv = *(const f32x4*)(DECl + d * 256 + 16 * kb + 4 * quad);
                S[pb][kb] = mfma16(trn(Kp, PK, 0, 16 * kb, lane), vfn, S[pb][kb] * dv); }
            if (NPB > 1) EPI_FENCE();
        }
        lds_barrier();
        {
            const bool wr = c > 0 || b == 0;
#pragma unroll
            for (int j = 0; j < NV; ++j) { const int id = tid + 512 * j, row = id / (VW / 8), sg = id % (VW / 8); float y[8]; unpack8(*(const u32x4*)(OT + row * PO + 8 * sg), y); float ss = 0.f;
                if (MODE == 2) { float xv[8], zv[8]; const bool ok = row < nv;
                    unpack8(ok ? *(const u32x4*)(M.XC() + (size_t)(row0 + row) * 1024 + 256 * hd + 128 * vs + 8 * sg) : zero4, xv); unpack8(ok ? *(const u32x4*)(M.PROJ() + (size_t)(row0 + row) * PWP + C_Z + 256 * hd + 128 * vs + 8 * sg) : zero4, zv);
                    const float Dh = M.d_skip()[4 * hd + 2 * vs + (sg >> 3)];
#pragma unroll
                    for (int i = 0; i < 8; ++i) y[i] = (y[i] + Dh * xv[i]) * silu(zv[i]); }
#pragma unroll
                for (int i = 0; i < 8; ++i) ss += y[i] * y[i];
                if (MODE != 1 && wr && row < nv) *(u32x4*)(gY + (size_t)(row0 + row) * ldY + 8 * sg) = pack8(y);
#pragma unroll
                for (int o = 1; o < 16; o <<= 1) ss += shflx(ss, o);
                if (MODE == 1) {
                    float gv[8]; unpack8((wr && row < nv) ? *(const u32x4*)(M.PROJ() + (size_t)(row0 + row) * PWP + C_HG + 128 * hd + 8 * sg) : zero4, gv); const float sc = 1.f / sqrtf(ss * (1.f / 128.f) + RMS_EPS);
                    const float* nw = M.in[I_HNW] + M.l * 1024 + 128 * hd + 8 * sg;
#pragma unroll
                    for (int i = 0; i < 8; ++i) y[i] = y[i] * sc * nw[i] * sigm(gv[i]);
                    if (wr && row < nv) *(u32x4*)(gY + (size_t)(row0 + row) * ldY + 8 * sg) = pack8(y); }
                if (wr && row < nv && (tid & 15) == 0) { if (MODE == 0) M.SSQR()[(size_t)(row0 + row) * 16 + 4 * hd + vs] = ss; else if (MODE == 1) M.SSQH()[(size_t)(row0 + row) * 8 + hd] = ss; else M.SSQM()[(size_t)(row0 + row) * 8 + 2 * hd + vs] = ss; }
            }
            if (c < NCH) SCAN_STORE(d ^ 1);
        }
        lds_barrier();
    }
#undef SCAN_FETCH
#undef SCAN_STORE
    if (MODE == 0) { float* so = M.ret_p() + ((size_t)(b * 4 + hd) * 256) * 512 + 128 * vs + v0 + l15;
#pragma unroll
        for (int kb = 0; kb < NKB; ++kb)
#pragma unroll
            for (int e = 0; e < 4; ++e) so[(size_t)(16 * kb + 4 * quad + e) * 512] = S[0][kb][e]; }
    if (MODE == 1) { float* so = M.hgrn_p() + ((size_t)(b * 8 + hd) * 128) * 128 + v0 + l15;
#pragma unroll
        for (int kb = 0; kb < NKB; ++kb)
#pragma unroll
            for (int e = 0; e < 4; ++e) so[(size_t)(16 * kb + 4 * quad + e) * 128] = S[0][kb][e]; }
    if (MODE == 2) {
#pragma unroll
        for (int pb = 0; pb < NPB; ++pb) { float* so = M.ssm_p() + ((size_t)(b * 16 + 4 * hd + hh) * 64 + 16 * (w & 3) + 16 * pb + l15) * 128;
#pragma unroll
            for (int nb = 0; nb < NKB; ++nb) *(f32x4*)(so + 16 * nb + 4 * quad) = S[pb][nb]; } }
    block_sync();
}
DEV float block_sum(float v, float* scr, int tid) {
    v = wave_sum(v); lds_barrier(); if ((tid & 63) == 0) scr[tid >> 6] = v; lds_barrier();
    float s = 0.f;
#pragma unroll
    for (int i = 0; i < 8; ++i) s += scr[i];
    return s;
}
DEV void ret_sample_unit(const Mix& M, unsigned char* lds, int sb, int h) {
    const int tid = TID_OPAQUE(), row = ROW_SMP + sb; const bf16_t* pr = M.PROJ() + (size_t)row * PWP;
    float* qv = (float*)lds; float* kv = qv + 256; float* vv = kv + 256; float* part = vv + 512; float* scr = part + 4 * 512;
    const int v4 = 4 * (tid & 127), r = tid >> 7;
    const float* Sin = M.ret_in() + ((size_t)(sb * 4 + h) * 256) * 512 + v4; float* Sout = M.ret_s() + ((size_t)(sb * 4 + h) * 256) * 512 + v4;
    f32x4 cur[8], nxt[8];
#pragma unroll
    for (int j = 0; j < 8; ++j) cur[j] = ldnt(Sin + (size_t)(4 * j + r) * 512);
    if (tid < 128) { const float* rp = M.rope() + (size_t)(ROPE_ROWS - 1) * 256; const float cs = rp[tid], sn = rp[128 + tid];
        float a1 = bf2f(pr[C_RQ + 256 * h + tid]), a2 = bf2f(pr[C_RQ + 256 * h + 128 + tid]); qv[tid] = a1 * cs - a2 * sn; qv[128 + tid] = a2 * cs + a1 * sn;
        a1 = bf2f(pr[C_RK + 256 * h + tid]); a2 = bf2f(pr[C_RK + 256 * h + 128 + tid]); kv[tid] = (a1 * cs - a2 * sn) * 0.0625f; kv[128 + tid] = (a2 * cs + a1 * sn) * 0.0625f; }
    vv[tid] = bf2f(pr[C_RV + 512 * h + tid]);
    lds_barrier();
    const float gam = expf(log_gamma(h));
    const f32x4 w4 = *(const f32x4*)(vv + v4); f32x4 o = {0.f, 0.f, 0.f, 0.f};
#pragma unroll
    for (int bt = 0; bt < 8; ++bt) {
        if (bt < 7) {
#pragma unroll
            for (int j = 0; j < 8; ++j) nxt[j] = ldnt(Sin + (size_t)(4 * (8 * (bt + 1) + j) + r) * 512); }
#pragma unroll
        for (int j = 0; j < 8; ++j) { const int k = 4 * (8 * bt + j) + r; const f32x4 sn = cur[j] * gam + w4 * kv[k]; stnt(Sout + (size_t)k * 512, sn); o += sn * qv[k]; }
#pragma unroll
        for (int j = 0; j < 8; ++j) cur[j] = nxt[j];
    }
    *(f32x4*)(part + r * 512 + v4) = o;
    lds_barrier();
    const float ov = (part[tid] + part[512 + tid]) + (part[1024 + tid] + part[1536 + tid]);
    M.YR()[(size_t)row * 2048 + 512 * h + tid] = f2bf(ov);
    const float ss = block_sum(ov * ov, scr, tid);
    if (tid < 4) M.SSQR()[(size_t)row * 16 + 4 * h + tid] = tid == 0 ? ss : 0.f;
    lds_barrier();
}
DEV void hgrn_sample_unit(const Mix& M, unsigned char* lds, int sb) {
    const int tid = TID_OPAQUE(), row = ROW_SMP + sb; const bf16_t* pr = M.PROJ() + (size_t)row * PWP;
    float* qv = (float*)lds; float* fv = qv + 1024; float* kv = fv + 1024; float* vv = kv + 1024; float* part = vv + 1024;
    const int v4 = 4 * (tid & 31), r = tid >> 5;
    const float* Sin = M.hgrn_in() + ((size_t)(sb * 8) * 128) * 128 + v4; float* Sout = M.hgrn_s() + ((size_t)(sb * 8) * 128) * 128 + v4;
    f32x4 cur[8], nxt[8];
#pragma unroll
    for (int j = 0; j < 8; ++j) cur[j] = ldnt(Sin + (size_t)(16 * j + r) * 128);
#pragma unroll
    for (int j = 0; j < 2; ++j) { const int c = tid + 512 * j; const float z = bf2f(pr[C_HF + c]), lbv = M.lb()[c]; const float sg = sigm(z);
        qv[c] = bf2f(pr[C_HQ + c]) * 0.08838834764831845f; fv[c] = lbv + (1.f - lbv) * sg; kv[c] = (1.f - lbv) * (1.f - sg); vv[c] = bf2f(pr[C_HI + c]); }
    lds_barrier();
#pragma unroll
    for (int h = 0; h < 8; ++h) {
        if (h < 7) {
#pragma unroll
            for (int j = 0; j < 8; ++j) nxt[j] = ldnt(Sin + (size_t)((h + 1) * 128 + 16 * j + r) * 128); }
        const f32x4 w4 = *(const f32x4*)(vv + 128 * h + v4); f32x4 o = {0.f, 0.f, 0.f, 0.f};
#pragma unroll
        for (int j = 0; j < 8; ++j) { const int k = 16 * j + r; const f32x4 sn = cur[j] * fv[128 * h + k] + w4 * kv[128 * h + k]; stnt(Sout + (size_t)(h * 128 + k) * 128, sn); o += sn * qv[128 * h + k]; }
        *(f32x4*)(part + (h * 16 + r) * 128 + v4) = o;
#pragma unroll
        for (int j = 0; j < 8; ++j) cur[j] = nxt[j];
    }
    lds_barrier();
    {
        const int w = tid >> 6, lane = tid & 63; float a = 0.f, b2 = 0.f;
#pragma unroll
        for (int i = 0; i < 16; ++i) { a += part[(w * 16 + i) * 128 + lane]; b2 += part[(w * 16 + i) * 128 + 64 + lane]; }
        const float ss = wave_sum(a * a + b2 * b2), sc = 1.f / sqrtf(ss * (1.f / 128.f) + RMS_EPS); const float* nw = M.in[I_HNW] + M.l * 1024 + 128 * w;
        M.YH()[(size_t)row * 1024 + 128 * w + lane] = f2bf(a * sc * nw[lane] * sigm(bf2f(pr[C_HG + 128 * w + lane]))); M.YH()[(size_t)row * 1024 + 128 * w + 64 + lane] = f2bf(b2 * sc * nw[64 + lane] * sigm(bf2f(pr[C_HG + 128 * w + 64 + lane])));
    }
    lds_barrier();
}
DEV void mamba_sample_unit(const Mix& M, unsigned char* lds, int sb) {
    const int tid = TID_OPAQUE(), row = ROW_SMP + sb; const bf16_t* pr = M.PROJ() + (size_t)row * PWP;
    float* xbc = (float*)lds; float* dtv = xbc + 2048; float* dav = dtv + 16; float* yv = dav + 16; float* scr = yv + 1024;
    const int n4 = 4 * (tid & 31), r = tid >> 5;
    const float* Sin = M.ssm_in() + ((size_t)(sb * 16) * 64) * 128 + n4; float* Sout = M.ssm_s() + ((size_t)(sb * 16) * 64) * 128 + n4;
    f32x4 cur[8], nxt[8];
#pragma unroll
    for (int j = 0; j < 8; ++j) cur[j] = ldnt(Sin + (size_t)((j >> 2) * 64 + 16 * (j & 3) + r) * 128);
    {
        const int c4 = 4 * tid; const float* cin = M.conv_in() + (size_t)sb * 3 * 2048 + c4; float* cout = M.conv_s() + (size_t)sb * 3 * 2048 + c4;
        const f32x4 r0 = *(const f32x4*)cin, r1 = *(const f32x4*)(cin + 2048), r2 = *(const f32x4*)(cin + 4096);
        f32x4 r3; r3[0] = bf2f(pr[C_X + c4]); r3[1] = bf2f(pr[C_X + c4 + 1]); r3[2] = bf2f(pr[C_X + c4 + 2]); r3[3] = bf2f(pr[C_X + c4 + 3]);
        f32x4 a = *(const f32x4*)(M.conv_b() + c4) + r0 * *(const f32x4*)(M.conv_w() + c4) + r1 * *(const f32x4*)(M.conv_w() + 2048 + c4) + r2 * *(const f32x4*)(M.conv_w() + 4096 + c4) + r3 * *(const f32x4*)(M.conv_w() + 6144 + c4);
#pragma unroll
        for (int i = 0; i < 4; ++i) xbc[c4 + i] = silu(a[i]);
        *(f32x4*)cout = r1; *(f32x4*)(cout + 2048) = r2; *(f32x4*)(cout + 4096) = r3;
    }
    if (tid < 16) { const float d = softplus(M.DT()[(size_t)row * 16 + tid] + M.dt_bias()[tid]); dtv[tid] = d; dav[tid] = expf(-d * expf(M.a_log()[tid])); }
    lds_barrier();
#pragma unroll
    for (int bt = 0; bt < 8; ++bt) {
        if (bt < 7) {
#pragma unroll
            for (int j = 0; j < 8; ++j) nxt[j] = ldnt(Sin + (size_t)((2 * (bt + 1) + (j >> 2)) * 64 + 16 * (j & 3) + r) * 128); }
#pragma unroll
        for (int hq = 0; hq < 2; ++hq) { const int h = 2 * bt + hq; const f32x4 B4 = *(const f32x4*)(xbc + 1024 + 128 * (bt >> 1) + n4), C4 = *(const f32x4*)(xbc + 1536 + 128 * (bt >> 1) + n4); const float da = dav[h], dt = dtv[h];
#pragma unroll
            for (int it = 0; it < 4; ++it) { const int p = 16 * it + r; const f32x4 sn = cur[4 * hq + it] * da + B4 * (dt * xbc[64 * h + p]); stnt(Sout + (size_t)(h * 64 + p) * 128, sn);
                float y = (sn[0] * C4[0] + sn[1] * C4[1]) + (sn[2] * C4[2] + sn[3] * C4[3]);
#pragma unroll
                for (int o = 1; o < 32; o <<= 1) y += shflx(y, o);
                if ((tid & 31) == 0) yv[64 * h + p] = y; } }
#pragma unroll
        for (int j = 0; j < 8; ++j) cur[j] = nxt[j];
    }
    lds_barrier();
#pragma unroll
    for (int j = 0; j < 2; ++j) { const int c = tid + 512 * j; const float y = (yv[c] + M.d_skip()[c >> 6] * xbc[c]) * silu(bf2f(pr[C_Z + c])); M.YM()[(size_t)row * 1024 + c] = f2bf(y);
        const float s = wave_sum(y * y); if ((tid & 63) == 0) scr[(tid >> 6) + 8 * j] = s; }
    lds_barrier();
    if (tid < 4) { const int g = tid; const int j = g >> 1, w0 = 4 * (g & 1); M.SSQM()[(size_t)row * 8 + 2 * g] = (scr[w0 + 8 * j] + scr[w0 + 1 + 8 * j]) + (scr[w0 + 2 + 8 * j] + scr[w0 + 3 + 8 * j]); M.SSQM()[(size_t)row * 8 + 2 * g + 1] = 0.f; }
    lds_barrier();
}

DEV void norm_pass(const Frame& F, const Mix& M, const float* m_norm_w, const float* h_norm_w) {
    const int gw = F.vcu * 8 + F.wave, NGW = F.G * 8, lane = F.lane;
    for (int r = gw; r < R_USED; r += NGW) {
        const bf16_t* pr = M.PROJ() + (size_t)r * PWP;
#pragma unroll
        for (int j = 0; j < 2; ++j) { const int c = 8 * lane + 512 * j; float y[8], g[8];
            unpack8(*(const u32x4*)(M.YM() + (size_t)r * 1024 + c), y); const float sc = 1.f / sqrtf((M.SSQM()[(size_t)r * 8 + 2 * (c >> 8)] + M.SSQM()[(size_t)r * 8 + 2 * (c >> 8) + 1]) * (1.f / 256.f) + RMS_EPS);
#pragma unroll
            for (int i = 0; i < 8; ++i) y[i] = y[i] * sc * m_norm_w[c + i];
            *(u32x4*)(M.YM() + (size_t)r * 1024 + c) = pack8(y);
}
#pragma unroll
        for (int j = 0; j < 4; ++j) { const int c = 8 * lane + 512 * j; float y[8], g[8]; const f32x4 q4 = *(const f32x4*)(M.SSQR() + (size_t)r * 16 + 4 * j);
            unpack8(*(const u32x4*)(M.YR() + (size_t)r * 2048 + c), y); unpack8(*(const u32x4*)(pr + C_RG + c), g); const float sr = 1.f / sqrtf(((q4[0] + q4[1]) + (q4[2] + q4[3])) * (1.f / 512.f) + RMS_EPS);
#pragma unroll
            for (int i = 0; i < 8; ++i) y[i] = y[i] * sr * silu(g[i]);
            *(u32x4*)(M.YR() + (size_t)r * 2048 + c) = pack8(y); }
    }
}

DEV void mixerA_phase(const Frame& F, const Mix& M, int mask = 7) {
    if (mask & 2) { const int u0 = F.vcu; if (u0 < 4 * NCI) { const int g = u0 % 4; MbRaw r; mambaA_cw(M, F.lds, g); mambaA_fetch(M, g, u0 / 4, F.tid, r);
        for (int u = u0; u < 4 * NCI; u += F.G) mambaA_unit(M, F.lds, u % 4, u / 4, r, u + F.G < 4 * NCI ? (u + F.G) / 4 : -1); } }
    if (mask & 1) { const int u0 = F.vcu; if (u0 < 4 * NCI) { RetRaw r; retA_fetch(M, u0 % 4, u0 / 4, F.tid, r);
        for (int u = u0; u < 4 * NCI; u += F.G) retA_unit(M, F.lds, u % 4, u / 4, r, u + F.G < 4 * NCI ? (u + F.G) / 4 : -1); } }
    if (mask & 4) { const int u0 = F.G - 1 - F.vcu; if (u0 < 8 * NCI) { HgRaw r; hgrnA_fetch(M, u0 % 8, u0 / 8, F.tid, r);
        for (int u = u0; u < 8 * NCI; u += F.G) hgrnA_unit(M, F.lds, u % 8, u / 8, r, u + F.G < 8 * NCI ? (u + F.G) / 8 : -1); } }
}
DEV void mixerB_phase(const Frame& F, const Mix& M, unsigned* qhead, int mask = 15) {
    constexpr int NU_R = NB * 16, NU_M = NB * 8, NU_H = NB * 8, NPU = NU_R + NU_M + NU_H, NSU = SB * 6;
    if (F.G * 7 >= NPU * 8) {
        const int nh2 = NU_H / 2;
        for (int u = F.vcu; u < NU_R + NU_M + nh2; u += F.G) {
            if (u < NU_R) { if (mask & 1) scan_unit<0>(M, F.lds, u / 16, (u / 4) % 4, u % 4); }
            else if (u < NU_R + NU_M) { if (mask & 2) scan_unit<2>(M, F.lds, (u - NU_R) / 8, ((u - NU_R) / 2) % 4, (u - NU_R) % 2); }
            else if (mask & 4) { const int v = 2 * (u - NU_R - NU_M); scan_unit<1>(M, F.lds, v / 8, v % 8, 0); scan_unit<1>(M, F.lds, (v + 1) / 8, (v + 1) % 8, 0); }
        }
    } else
    for (int u = F.vcu; u < NPU; u += F.G) {
        if (u < NU_R) { if (mask & 1) scan_unit<0>(M, F.lds, u / 16, (u / 4) % 4, u % 4); }
        else if (u < NU_R + NU_M) { if (mask & 2) scan_unit<2>(M, F.lds, (u - NU_R) / 8, ((u - NU_R) / 2) % 4, (u - NU_R) % 2); }
        else { if (mask & 4) scan_unit<1>(M, F.lds, (u - NU_R - NU_M) / 8, (u - NU_R - NU_M) % 8, 0); }
    }
    if (!(mask & 8)) return;
    unsigned* slot = (unsigned*)(F.lds + 131072 + 64);
    unsigned nx = 0u; if (F.tid == 0) nx = queue_pop(qhead);
    for (;;) {
        if (F.tid == 0) *slot = nx;
        lds_barrier();
        const int u = (int)*slot;
        lds_barrier();
        if (u >= NSU) break;
        if (F.tid == 0) nx = queue_pop(qhead);
        if (u < SB * 4) ret_sample_unit(M, F.lds, u / 4, u % 4);
        else if (u < SB * 5) hgrn_sample_unit(M, F.lds, u - SB * 4);
        else mamba_sample_unit(M, F.lds, u - SB * 5);
    }
}
constexpr int LDS_BYTES = 147456, LDSCTL_OFF = 131072;
constexpr int PPL = 10, N_PHASES = 1 + PPL * DEPTH;
#ifndef MK_N_LAUNCHES
#define MK_N_LAUNCHES 1
#endif
#ifndef REP_G1
#define REP_G1 1
#endif
#ifndef REP_MIX
#define REP_MIX 1
#endif
#ifndef REP_NORM
#define REP_NORM 1
#endif
#ifndef REP_BR
#define REP_BR 1
#endif
#ifndef REP_WO
#define REP_WO 1
#endif
#ifndef REP_LN1
#define REP_LN1 1
#endif
#ifndef REP_FI
#define REP_FI 1
#endif
#ifndef REP_FO
#define REP_FO 1
#endif
#ifndef REP_LN2
#define REP_LN2 1
#endif
#ifndef REP_P0
#define REP_P0 1
#endif
#ifndef REP_MIXB
#define REP_MIXB 1
#endif
#ifndef PROBE_UMASK
#define PROBE_UMASK 7
#endif
#ifndef EMU
#define PROBE_UMASK_EXPR (rep_ == 0 ? 7 : PROBE_UMASK)
#else
#define PROBE_UMASK_EXPR 7
#endif
struct Args { const float* in[28]; float* out; unsigned char* ws; int ph_lo, ph_hi; };

DEV void mix_init(Mix& M, const Frame& P, int l) { M.ws = P.ws; M.out = P.out; M.in = P.in; M.l = l; }
DEV void run_phases(Frame& F, int lo, int hi
#ifndef EMU
    , const XcdBarrier& bar
#endif
) {
#ifndef PHASE_MASK
#define PHASE_MASK 0x7ff
#endif
#define IN(k) (lo <= (k) && (k) < hi)
#define PM(b) ((PHASE_MASK >> (b)) & 1)
#ifndef EMU
#define SEAM(k) do { if (IN(k) && IN((k) + 1)) xcd_barrier(bar); } while (0)
#else
#define SEAM(k) do { } while (0)
#endif
#ifndef EMU
#define PH Frame P = F; { int t_ = F.tid; asm volatile("" : "+v"(t_)); P.tid = t_; P.lane = t_ & 63; P.wave = __builtin_amdgcn_readfirstlane(t_ >> 6); unsigned char* w_ = F.ws; asm volatile("" : "+s"(w_)); P.ws = w_; P.ctl = (unsigned*)(w_ + WS_CTL); \
    const float* const* i_ = F.in; asm volatile("" : "+s"(i_)); P.in = i_; float* o_ = F.out; asm volatile("" : "+s"(o_)); P.out = o_; } unsigned char* const ws = P.ws; (void)ws
#else
#define PH Frame P = F; unsigned char* const ws = P.ws; (void)ws
#endif
#define WSP(T, off) ((T*)(ws + (off)))
#ifndef EMU
#define REPEAT(n) _Pragma("unroll 1") for (int rep_ = 0; rep_ < (n); (void)((++rep_ < (n)) ? (xcd_barrier(bar), 0) : 0))
#else
#define REPEAT(n)
#endif
    if (PM(0) && IN(0)) REPEAT(REP_P0) { PH; p0_prologue(P); } SEAM(0);
    for (int l = 0; l < DEPTH; ++l) {
        const int base = 1 + PPL * l;
        if (PM(1) && IN(base + 0)) REPEAT(REP_G1) {
            PH; pg8::Gemm g{WSP(bf16_t, WS_XN), (const bf16_t*)(ws + WS_W1T + l * SZ_W1T), RP, PW, 1024}; pg8::StaticOrder S; S.init(RP, PW, P.G, BID()); EpiProj E{WSP(bf16_t, WS_PROJ), WSP(float, WS_DT)};
            pg8::gemm_phase<EpiProj, pg8::StaticOrder, false, true>((PG8_LAS unsigned char*)P.lds, g, S, E);
            { SkProj f{(const bf16_t*)(ws + WS_W1T + l * SZ_W1T), WSP(bf16_t, WS_PROJ), WSP(float, WS_DT)}; skinny_gemm(WSP(bf16_t, WS_XN) + (size_t)RP * 1024, 1024, 257, P.G - 1 - P.vcu, P.G, f, P.lds);
              dt_gemm(WSP(bf16_t, WS_XN), (const bf16_t*)(ws + WS_W1T + l * SZ_W1T) + (size_t)PW * 1024, WSP(float, WS_DT), P.vcu, P.G); }
        } SEAM(base + 0);
        if (PM(2) && IN(base + 1)) REPEAT(REP_MIX) { PH; Mix M; mix_init(M, P, l); mixerA_phase(P, M); } SEAM(base + 1);
        if (PM(3) && IN(base + 2)) REPEAT(REP_MIXB) { PH; Mix M; mix_init(M, P, l); mixerB_phase(P, M, P.ctl + CW_QUEUE + 64 * l); } SEAM(base + 2);

        if (PM(4) && IN(base + 3)) REPEAT(REP_NORM) { PH; Mix M; mix_init(M, P, l); norm_pass(P, M, P.in[I_MNW] + l * 1024, P.in[I_HNW] + l * 1024); } SEAM(base + 3);
        if (PM(5) && IN(base + 4)) REPEAT(REP_BR) {
            { PH; pg8::StaticOrder S; S.init(RP, 1024, P.G, BID()); pg8::Gemm g{WSP(bf16_t, WS_YM), (const bf16_t*)(ws + WS_WMT + l * SZ_WSQ), RP, 1024, 1024}; EpiBranch<0> E{WSP(bf16_t, WS_PROJ) + C_GATE, WSP(float, WS_MIX), WSP(bf16_t, WS_MIXB)};
              pg8::gemm_phase<EpiBranch<0>, pg8::StaticOrder, true, true>((PG8_LAS unsigned char*)P.lds, g, S, E);
              SkBranch<0> f{(const bf16_t*)(ws + WS_WMT + l * SZ_WSQ), 1024, WSP(bf16_t, WS_PROJ) + C_GATE, WSP(float, WS_MIX), WSP(bf16_t, WS_MIXB)}; skinny_gemm(WSP(bf16_t, WS_YM) + (size_t)RP * 1024, 1024, 16, P.G - 1 - P.vcu, P.G, f, P.lds); }
            { PH; pg8::StaticOrder S; S.init(RP, 1024, P.G, BID()); pg8::Gemm g{WSP(bf16_t, WS_YH), (const bf16_t*)(ws + WS_WHT + l * SZ_WSQ), RP, 1024, 1024}; EpiBranch<1> E{WSP(bf16_t, WS_PROJ) + C_GATE + 1024, WSP(float, WS_MIX), WSP(bf16_t, WS_MIXB)};
              pg8::gemm_phase<EpiBranch<1>, pg8::StaticOrder, true, true>((PG8_LAS unsigned char*)P.lds, g, S, E);
              SkBranch<1> f{(const bf16_t*)(ws + WS_WHT + l * SZ_WSQ), 1024, WSP(bf16_t, WS_PROJ) + C_GATE + 1024, WSP(float, WS_MIX), WSP(bf16_t, WS_MIXB)}; skinny_gemm(WSP(bf16_t, WS_YH) + (size_t)RP * 1024, 1024, 16, P.G - 1 - P.vcu, P.G, f, P.lds); }
            { PH; pg8::StaticOrder S; S.init(RP, 1024, P.G, BID()); pg8::Gemm g{WSP(bf16_t, WS_YR), (const bf16_t*)(ws + WS_WRT + l * SZ_WRT), RP, 1024, 2048}; EpiBranch<2> E{WSP(bf16_t, WS_PROJ) + C_GATE + 2048, WSP(float, WS_MIX), WSP(bf16_t, WS_MIXB)};
              pg8::gemm_phase<EpiBranch<2>, pg8::StaticOrder, true, true>((PG8_LAS unsigned char*)P.lds, g, S, E);
              SkBranch<2> f{(const bf16_t*)(ws + WS_WRT + l * SZ_WRT), 2048, WSP(bf16_t, WS_PROJ) + C_GATE + 2048, WSP(float, WS_MIX), WSP(bf16_t, WS_MIXB)}; skinny_gemm(WSP(bf16_t, WS_YR) + (size_t)RP * 2048, 2048, 16, P.G - 1 - P.vcu, P.G, f, P.lds); }
        } SEAM(base + 4);
        if (PM(6) && IN(base + 5)) REPEAT(REP_WO) {
            PH; pg8::Gemm g{WSP(bf16_t, WS_MIXB), (const bf16_t*)(ws + WS_WOT + l * SZ_WSQ), RP, 1024, 1024}; pg8::StaticOrder S; S.init(RP, 1024, P.G, BID()); EpiResid E{WSP(float, WS_X), WSP(float, WS_XPRE)};
            pg8::gemm_phase<EpiResid, pg8::StaticOrder, true, true>((PG8_LAS unsigned char*)P.lds, g, S, E);
            { SkResid f{(const bf16_t*)(ws + WS_WOT + l * SZ_WSQ), 1024, WSP(float, WS_X), WSP(float, WS_XPRE)}; skinny_gemm(WSP(bf16_t, WS_MIXB) + (size_t)RP * 1024, 1024, 16, P.G - 1 - P.vcu, P.G, f, P.lds); }
        } SEAM(base + 5);
        if (PM(7) && IN(base + 6)) REPEAT(REP_LN1) { PH; ln_pass(P, P.in[I_LN1G] + l * 1024, P.in[I_LN1B] + l * 1024, false); } SEAM(base + 6);
        if (PM(8) && IN(base + 7)) REPEAT(REP_FI) {
            PH; pg8::Gemm g{WSP(bf16_t, WS_XN), (const bf16_t*)(ws + WS_WFIT + l * SZ_WFIT), RP, 2 * DFF, 1024}; pg8::StaticOrder S; S.init(RP, 2 * DFF, P.G, BID()); EpiSwiGLU E{WSP(bf16_t, WS_HB)};
            pg8::gemm_phase<EpiSwiGLU, pg8::StaticOrder, true, true>((PG8_LAS unsigned char*)P.lds, g, S, E);
            { SkSwiGLU f{(const bf16_t*)(ws + WS_WFIT + l * SZ_WFIT), WSP(bf16_t, WS_HB)}; skinny_gemm(WSP(bf16_t, WS_XN) + (size_t)RP * 1024, 1024, DFF / 32, P.G - 1 - P.vcu, P.G, f, P.lds); }
        } SEAM(base + 7);
        if (PM(9) && IN(base + 8)) REPEAT(REP_FO) {
            PH; pg8::Gemm g{WSP(bf16_t, WS_HB), (const bf16_t*)(ws + WS_WFOT + l * SZ_WFOT), RP, 1024, DFF}; pg8::StaticOrder S; S.init(RP, 1024, P.G, BID()); EpiResid E{WSP(float, WS_X), WSP(float, WS_XPRE)};
            pg8::gemm_phase<EpiResid, pg8::StaticOrder, true, true>((PG8_LAS unsigned char*)P.lds, g, S, E);
            { SkResid f{(const bf16_t*)(ws + WS_WFOT + l * SZ_WFOT), DFF, WSP(float, WS_X), WSP(float, WS_XPRE)}; skinny_gemm(WSP(bf16_t, WS_HB) + (size_t)RP * DFF, DFF, 16, P.G - 1 - P.vcu, P.G, f, P.lds); }
        } SEAM(base + 8);
        if (PM(10) && IN(base + 9)) REPEAT(REP_LN2) { PH; ln_pass(P, P.in[I_LN2G] + l * 1024, P.in[I_LN2B] + l * 1024, l == DEPTH - 1); } SEAM(base + 9);
    }
#undef PH
#undef WSP
#undef IN
#undef SEAM
}

#ifndef EMU
__global__ void __launch_bounds__(512, 2) hybrid_fwd(Args args) {
    extern __shared__ __attribute__((aligned(16))) unsigned char lds[];
    Frame F;
    F.lds = lds; F.tid = threadIdx.x; F.lane = F.tid & 63; F.wave = __builtin_amdgcn_readfirstlane(F.tid >> 6);
    F.G = gridDim.x; { const int bx = blockIdx.x; F.vcu = (F.G % 8 == 0) ? (bx % 8) * (F.G / 8) + bx / 8 : bx; }
    F.in = (const float* const*)__builtin_amdgcn_kernarg_segment_ptr();
    F.out = args.out; F.ws = args.ws; F.ctl = (unsigned*)(args.ws + WS_CTL);
    for (int u = F.tid; u < (LDS_BYTES - LDSCTL_OFF) / 4; u += 512) ((unsigned*)(lds + LDSCTL_OFF))[u] = 0u;
    __syncthreads();
    XcdBarrier bar; bar.bar = F.ctl + CW_BAR; bar.x = 0; bar.st = nullptr;
    if (MK_N_LAUNCHES == 1) bar = xcd_barrier_post(F.ctl + CW_BAR, (volatile LAS unsigned*)(lds + LDSCTL_OFF));
    run_phases(F, args.ph_lo, args.ph_hi, bar);
}

extern "C" void kernel_launch(void* const* d_in, const int* in_sizes, int n_in, void* d_out, int out_size, void* d_ws, size_t ws_size, hipStream_t stream) {
    static int grid = 0;
    if (grid == 0) {
        if (n_in != 28 || (size_t)out_size != O_END || ws_size < WS_END) { fprintf(stderr, "kernel_launch: unexpected shapes (n_in %d, out %d, ws %zu; need 28, %zu, >= %zu); nothing launched\n", n_in, out_size, ws_size, (size_t)O_END, (size_t)WS_END); grid = -1; return; }
        int dev = 0, cus = 0, per_cu = 0;
        if (hipGetDevice(&dev) != hipSuccess || hipDeviceGetAttribute(&cus, hipDeviceAttributeMultiprocessorCount, dev) != hipSuccess) { grid = -1; return; }
        if (hipFuncSetAttribute((const void*)hybrid_fwd, hipFuncAttributeMaxDynamicSharedMemorySize, LDS_BYTES) != hipSuccess) { fprintf(stderr, "kernel_launch: hipFuncSetAttribute failed\n"); grid = -1; return; }
        if (hipOccupancyMaxActiveBlocksPerMultiprocessor(&per_cu, (const void*)hybrid_fwd, 512, LDS_BYTES) != hipSuccess || per_cu < 1) fprintf(stderr, "kernel_launch: occupancy query reports %d\n", per_cu);
        (void)hipGetLastError();
        grid = cus;
    }
    if (grid < 0) return;
    if (hipMemsetAsync((char*)d_ws + WS_CTL, 0, CTL_ZERO_BYTES, stream) != hipSuccess) return;
    Args a{};
    for (int i = 0; i < 28; ++i) a.in[i] = (const float*)d_in[i];
    a.out = (float*)d_out; a.ws = (unsigned char*)d_ws;
    if (MK_N_LAUNCHES == 1) { a.ph_lo = 0; a.ph_hi = N_PHASES; hipLaunchKernelGGL(hybrid_fwd, dim3(grid), dim3(512), LDS_BYTES, stream, a); }
    else for (int p = 0; p < N_PHASES; ++p) { a.ph_lo = p; a.ph_hi = p + 1; hipLaunchKernelGGL(hybrid_fwd, dim3(grid), dim3(512), LDS_BYTES, stream, a); }
}
#endif
```

```cpp
#ifndef EMU
#include <hip/hip_runtime.h>
#include <cstdio>
#include <cstdint>
#define DEV __device__ __forceinline__
#define HD __host__ __device__ __forceinline__
#else
#include "emu.h"
#endif

#ifndef CFG_BATCH
#define CFG_BATCH 8
#define CFG_SEQ 2048
#define CFG_DEC 128
#endif
constexpr int D = 1024, NB = CFG_BATCH, SEQ = CFG_SEQ, SB = CFG_DEC, DEPTH = 2, NMETA = 16, PAST = 16384;
constexpr int RP = NB * SEQ, ROW_META = RP, ROW_SMP = RP + NMETA, R_USED = RP + NMETA + SB, R = ((R_USED + 255) / 256) * 256;
constexpr int NCH = SEQ / 32;
constexpr int NCI = NB * NCH + 1;
constexpr int IN_DIM = 16400, PW = 16384, PWP = PW + 128, N1 = 16640;
constexpr int C_Z = 0, C_X = 1024, C_B = 2048, C_C = 2560, C_HQ = 3072, C_HF = 4096, C_HI = 5120, C_HG = 6144, C_RQ = 7168, C_RK = 8192, C_RV = 9216, C_RG = 11264, C_GATE = 13312;
constexpr int DFF = 2816;
constexpr float LN_EPS = 1e-5f, RMS_EPS = 1e-6f, DN_ALPHA = 1.41421356237f;
constexpr int ROPE_ROWS = SEQ + NMETA + 1;
constexpr size_t O_YP = 0, O_YS = O_YP + (size_t)RP * D, O_SSMP = O_YS + (size_t)SB * D, SZ_SSMP = (size_t)NB * 16 * 64 * 128, O_CONVP = O_SSMP + DEPTH * SZ_SSMP, SZ_CONVP = (size_t)NB * 3 * 2048,
    O_HGP = O_CONVP + DEPTH * SZ_CONVP, SZ_HGP = (size_t)NB * 8 * 128 * 128, O_RETP = O_HGP + DEPTH * SZ_HGP, SZ_RETP = (size_t)NB * 4 * 256 * 512,
    O_SSMS = O_RETP + DEPTH * SZ_RETP, SZ_SSMS = (size_t)SB * 16 * 64 * 128, O_CONVS = O_SSMS + DEPTH * SZ_SSMS, SZ_CONVS = (size_t)SB * 3 * 2048,
    O_HGS = O_CONVS + DEPTH * SZ_CONVS, SZ_HGS = (size_t)SB * 8 * 128 * 128, O_RETS = O_HGS + DEPTH * SZ_HGS, SZ_RETS = (size_t)SB * 4 * 256 * 512, O_END = O_RETS + DEPTH * SZ_RETS;

constexpr size_t al256(size_t x) { return (x + 255) & ~(size_t)255; }
constexpr size_t WS_CTL = 0, CTL_ZERO_BYTES = 1u << 20;
constexpr size_t SZ_W1T = (size_t)N1 * 1024 * 2, SZ_WSQ = (size_t)1024 * 1024 * 2, SZ_WRT = (size_t)1024 * 2048 * 2, SZ_WFIT = (size_t)2 * DFF * 1024 * 2, SZ_WFOT = (size_t)1024 * DFF * 2;
constexpr size_t WS_W1T = CTL_ZERO_BYTES, WS_WMT = WS_W1T + DEPTH * SZ_W1T, WS_WHT = WS_WMT + DEPTH * SZ_WSQ, WS_WRT = WS_WHT + DEPTH * SZ_WSQ, WS_WOT = WS_WRT + DEPTH * SZ_WRT,
    WS_WFIT = WS_WOT + DEPTH * SZ_WSQ, WS_WFOT = WS_WFIT + DEPTH * SZ_WFIT, WS_ROPE = WS_WFOT + DEPTH * SZ_WFOT, WS_LB = al256(WS_ROPE + (size_t)ROPE_ROWS * 256 * 4),
    WS_X = al256(WS_LB + DEPTH * 1024 * 4), WS_XPRE = WS_X + (size_t)R * D * 4, WS_XN = WS_XPRE + (size_t)R * D * 4, WS_PROJ = WS_XN + (size_t)R * D * 2, WS_DT = WS_PROJ + (size_t)R * PWP * 2,
    WS_YM = al256(WS_DT + (size_t)R * 16 * 4), WS_YH = WS_YM + (size_t)R * 1024 * 2, WS_YR = WS_YH + (size_t)R * 1024 * 2, WS_SSQM = WS_YR + (size_t)R * 2048 * 2, WS_SSQH = al256(WS_SSQM + (size_t)R * 8 * 4),
    WS_SSQR = al256(WS_SSQH + (size_t)R * 8 * 4), WS_MIX = al256(WS_SSQR + (size_t)R * 16 * 4), WS_MIXB = WS_MIX + (size_t)R * D * 4, WS_HB = WS_MIXB + (size_t)R * D * 2,
    WS_XC = al256(WS_HB + (size_t)R * DFF * 2), WS_BC = WS_XC + (size_t)R * 1024 * 2, WS_CC = WS_BC + (size_t)R * 512 * 2, WS_XW = WS_CC + (size_t)R * 512 * 2,
    WS_HDEC = WS_XW + (size_t)R * 1024 * 2, WS_ECUM = al256(WS_HDEC + (size_t)NCI * 8 * 128 * 4), WS_MDEC = al256(WS_ECUM + (size_t)NCI * 16 * 32 * 4), WS_END = al256(WS_MDEC + (size_t)NCI * 16 * 4);
constexpr int CW_TMO = 0, CW_CODE = 1, CW_QUEUE = 64  , CW_BAR = 4096;

typedef unsigned short bf16_t;
typedef short bf16x8 __attribute__((ext_vector_type(8)));
typedef short bf16x4 __attribute__((ext_vector_type(4)));
typedef float f32x4 __attribute__((ext_vector_type(4)));
typedef unsigned u32x4 __attribute__((ext_vector_type(4)));
typedef unsigned u32x2 __attribute__((ext_vector_type(2)));

#ifndef EMU
DEV int TID() { return threadIdx.x; }
DEV int TID_OPAQUE() { int t = threadIdx.x; asm volatile("" : "+v"(t)); return t; }
DEV int BID() { return blockIdx.x; }
DEV int NBLK() { return gridDim.x; }
DEV void block_sync() { __syncthreads(); }
DEV void lds_barrier() { asm volatile("s_waitcnt lgkmcnt(0)" ::: "memory"); __builtin_amdgcn_s_barrier(); asm volatile("" ::: "memory"); }
DEV void wave_sync() { asm volatile("s_waitcnt lgkmcnt(0)" ::: "memory"); }
DEV f32x4 mfma16(bf16x8 a, bf16x8 b, f32x4 c) { return __builtin_amdgcn_mfma_f32_16x16x32_bf16(a, b, c, 0, 0, 0); }
DEV float shflx(float v, int m) { return __shfl_xor(v, m); }
DEV int uniform(int v) { return __builtin_amdgcn_readfirstlane(v); }
DEV float fexp(float x) { return __expf(x); }
DEV float frcp(float x) { return __builtin_amdgcn_rcpf(x); }
typedef short s16x4_t __attribute__((ext_vector_type(4)));
DEV bf16x4 ds_tr4(const bf16_t* p) { return __builtin_amdgcn_ds_read_tr16_b64_v4i16((__attribute__((address_space(3))) s16x4_t*)p); }
DEV float flog(float x) { return __logf(x); }
DEV unsigned queue_pop(unsigned* p) { return __hip_atomic_fetch_add(p, 1u, __ATOMIC_RELAXED, __HIP_MEMORY_SCOPE_AGENT); }
typedef float f32x2_t __attribute__((ext_vector_type(2)));
typedef __bf16 bf16x2_t __attribute__((ext_vector_type(2)));
DEV unsigned pk2(float lo, float hi) { const f32x2_t v = {lo, hi}; return __builtin_bit_cast(unsigned, __builtin_convertvector(v, bf16x2_t)); }
#endif
DEV float u2f(unsigned u) { return __builtin_bit_cast(float, u); }
DEV unsigned f2u(float f) { return __builtin_bit_cast(unsigned, f); }
DEV float bf2f(bf16_t v) { return u2f((unsigned)v << 16); }
DEV bf16_t f2bf(float f) { return (bf16_t)(pk2(f, 0.f) & 0xffffu); }
DEV float sigm(float x) { return frcp(1.f + fexp(-x)); }
DEV float silu(float x) { return x * frcp(1.f + fexp(-x)); }
DEV float softplus(float x) { return x > 20.f ? x : flog(1.f + fexp(x)); }
DEV void unpack8(u32x4 w, float (&f)[8]) { f[0] = u2f(w.x << 16); f[1] = u2f(w.x & 0xffff0000u); f[2] = u2f(w.y << 16); f[3] = u2f(w.y & 0xffff0000u); f[4] = u2f(w.z << 16); f[5] = u2f(w.z & 0xffff0000u); f[6] = u2f(w.w << 16); f[7] = u2f(w.w & 0xffff0000u); }
DEV u32x4 pack8(const float (&f)[8]) { u32x4 w; w.x = pk2(f[0], f[1]); w.y = pk2(f[2], f[3]); w.z = pk2(f[4], f[5]); w.w = pk2(f[6], f[7]); return w; }
DEV bf16x8 pack8v(f32x4 a, f32x4 b) { u32x4 w; w.x = pk2(a[0], a[1]); w.y = pk2(a[2], a[3]); w.z = pk2(b[0], b[1]); w.w = pk2(b[2], b[3]); return __builtin_bit_cast(bf16x8, w); }
DEV u32x2 pk4(f32x4 v) { u32x2 w; w.x = pk2(v[0], v[1]); w.y = pk2(v[2], v[3]); return w; }
DEV float wave_sum(float v) {
#pragma unroll
    for (int o = 1; o < 64; o <<= 1) v += shflx(v, o);
    return v;
}
DEV bf16x8 frag(const bf16_t* tile, int ld, int row, int k0) { return *(const bf16x8*)(tile + row * ld + k0); }
DEV bf16x8 fragp(const bf16_t* tile, int ld, int row, int kbase, int quad) {
    const bf16x4 lo = *(const bf16x4*)(tile + row * ld + kbase + 4 * quad), hi = *(const bf16x4*)(tile + row * ld + kbase + 16 + 4 * quad);
    bf16x8 r; r[0] = lo[0]; r[1] = lo[1]; r[2] = lo[2]; r[3] = lo[3]; r[4] = hi[0]; r[5] = hi[1]; r[6] = hi[2]; r[7] = hi[3]; return r;
}
DEV bf16x8 trpair(const bf16_t* tile, int ld, int rowA, int rowB, int col0, int lane) {
    const int q = (lane & 15) >> 2, p = lane & 3; const bf16x4 lo = ds_tr4(tile + (rowA + q) * ld + col0 + 4 * p), hi = ds_tr4(tile + (rowB + q) * ld + col0 + 4 * p);
    bf16x8 r; r[0] = lo[0]; r[1] = lo[1]; r[2] = lo[2]; r[3] = lo[3]; r[4] = hi[0]; r[5] = hi[1]; r[6] = hi[2]; r[7] = hi[3]; return r;
}
DEV bf16x8 trn(const bf16_t* tile, int ld, int r0, int col0, int lane) { const int g = lane >> 4; return trpair(tile, ld, r0 + 8 * g, r0 + 8 * g + 4, col0, lane); }
DEV bf16x8 trp(const bf16_t* tile, int ld, int r0, int col0, int lane) { const int g = lane >> 4; return trpair(tile, ld, r0 + 4 * g, r0 + 16 + 4 * g, col0, lane); }
#ifndef EMU
DEV f32x4 ldnt(const float* p) { return __builtin_nontemporal_load((const f32x4*)p); }
DEV void stnt(float* p, f32x4 v) { __builtin_nontemporal_store(v, (f32x4*)p); }
#else
DEV f32x4 ldnt(const float* p) { return *(const f32x4*)p; }
DEV void stnt(float* p, f32x4 v) { *(f32x4*)p = v; }
#endif
namespace pg8 {
#ifndef EMU
#define PG8_LAS __attribute__((address_space(3)))
#else
#define PG8_LAS
#endif
typedef unsigned short bf16_t;
typedef short bf16x8 __attribute__((ext_vector_type(8)));
typedef float f32x4 __attribute__((ext_vector_type(4)));
typedef unsigned u32x4 __attribute__((ext_vector_type(4)));
constexpr int BM = 256, BK = 64, HALF = 128, HTB = HALF * BK * 2  , STAGE_BYTES = 8 * HTB, NXCD = 8, WGM = 8;
HD int lds_byte(int r, int c) { const int st = (r >> 4) * 2 + (c >> 5), rr = r & 15, cc = c & 31, ob = rr * 64 + cc * 2; return st * 1024 + (ob ^ (((ob >> 9) & 1) << 5)); }
HD void stage_rc(int b, int& R, int& C) { const int st = b / 1024, sb = b % 1024, swz = sb ^ (((sb >> 9) & 1) << 5); R = (st >> 1) * 16 + swz / 64; C = (st & 1) * 32 + (swz % 64) / 2; }
HD int perm32(int rho) { const int n = rho >> 4, i = rho & 15; return 8 * (i >> 2) + 4 * n + (i & 3); }
struct Unit { int pm, pn; };
struct Gemm { const bf16_t* A; const bf16_t* Bt; int M, N, K; };
struct StaticOrder {
    int nM, nN, nwg, G, c;
    HD void init(int M, int N, int G_, int c_) { nM = M / BM; nN = N / BM; nwg = nM * nN; G = G_; c = c_; }
    HD bool next(int i, Unit& u) const {
        const long L = (long)i * G + c; if (L >= nwg) return false;
        int wgid = (int)L; { const int q = nwg / NXCD, r = nwg % NXCD, xcd = wgid % NXCD, off = wgid / NXCD; wgid = (xcd < r ? xcd * (q + 1) : r * (q + 1) + (xcd - r) * q) + off; }
        const int nig = WGM * nN, gid = wgid / nig, fm = gid * WGM, gsz = (nM - fm) < WGM ? (nM - fm) : WGM;
        u.pm = fm + ((wgid % nig) % gsz); u.pn = (wgid % nig) / gsz; return true;
    }
    DEV void a_ready(const Unit&) const {}
    DEV void done(const Unit&) const {}
};
#ifndef EMU
template <class Epi, class Sched, bool ALIGN_EPI = false, bool SP2 = false>
__device__ __forceinline__ void gemm_phase(PG8_LAS unsigned char* lds, const Gemm g, const Sched& S, const Epi& E) {
    int tid_ = threadIdx.x; asm volatile("" : "+v"(tid_));
    const int tid = tid_, wid = __builtin_amdgcn_readfirstlane(tid >> 6), lane = tid & 63, wr = wid >> 2, wc = wid & 3, fr = lane & 15, fq = lane >> 4;
    const int K = g.K, nt = K / BK;
    unsigned voffA[2], voffB[2];
#pragma unroll
    for (int i = 0; i < 2; ++i) { int R, C; stage_rc(tid * 16 + i * 8192, R, C); const int Rb = Epi::PERM ? ((R & ~31) + perm32(R & 31)) : R;
        voffA[i] = (unsigned)(R * K + C) * 2u; voffB[i] = (unsigned)(Rb * K + C) * 2u; }
    const size_t kstep = (size_t)(BK * 2);
    const size_t hstep = (size_t)HALF * K * 2;
    const size_t tstep = 2 * hstep;
    const unsigned ldsw = (unsigned)wid * 1024u;
    const int aoff = lds_byte(wr * 64 + fr, fq * 8), boff = lds_byte(wc * 32 + fr, fq * 8);
#define PG8_SA(b, h) (((b) * 2 + (h)) * HTB)
#define PG8_SB(b, h) ((4 + (b) * 2 + (h)) * HTB)
#define PG8_STAGE(bufoff, gbase, voff) do { _Pragma("unroll") for (int _i = 0; _i < 2; ++_i) \
        __builtin_amdgcn_global_load_lds((const unsigned*)((const char*)(gbase) + (voff)[_i]), (PG8_LAS unsigned*)(lds + (bufoff) + ldsw + _i * 8192), 16, 0, 0); } while (0)
#define PG8_LDA(dst, b, h) do { _Pragma("unroll") for (int m = 0; m < 4; ++m) _Pragma("unroll") for (int k = 0; k < 2; ++k) dst[m][k] = *(const PG8_LAS bf16x8*)(lds + PG8_SA(b, h) + aoff + m * 2048 + k * 1024); } while (0)
#define PG8_LDB(dst, b, h) do { _Pragma("unroll") for (int n = 0; n < 2; ++n) _Pragma("unroll") for (int k = 0; k < 2; ++k) dst[n][k] = *(const PG8_LAS bf16x8*)(lds + PG8_SB(b, h) + boff + n * 2048 + k * 1024); } while (0)
#define PG8_MMA(ai, bj, At, Bt) do { __builtin_amdgcn_s_setprio(1); _Pragma("unroll") for (int m = 0; m < 4; ++m) _Pragma("unroll") for (int n = 0; n < 2; ++n) _Pragma("unroll") for (int k = 0; k < 2; ++k) \
        acc[ai][bj][m][n] = __builtin_amdgcn_mfma_f32_16x16x32_bf16(Bt[n][k], At[m][k], acc[ai][bj][m][n], 0, 0, 0); __builtin_amdgcn_s_setprio(0); } while (0)
#define PG8_WAIT_V(n) asm volatile("s_waitcnt vmcnt(" #n ")" ::: "memory")
#define PG8_WAIT_L(n) asm volatile("s_waitcnt lgkmcnt(" #n ")" ::: "memory")
#define PG8_BAR __builtin_amdgcn_s_barrier()
#define PG8_SCHED __builtin_amdgcn_sched_barrier(0)
    Unit cur, nxt; int ui = 0;
    if (!S.next(0, cur)) return;
    f32x4 acc[2][2][4][2];
#pragma unroll
    for (int a = 0; a < 2; ++a)
#pragma unroll
        for (int b = 0; b < 2; ++b)
#pragma unroll
            for (int m = 0; m < 4; ++m)
#pragma unroll
                for (int n = 0; n < 2; ++n) acc[a][b][m][n] = (f32x4){0.f, 0.f, 0.f, 0.f};
    bf16x8 At[4][2], B0[2][2], B1[2][2];
    const char* cA = (const char*)g.A + (size_t)cur.pm * tstep; const char* cB = (const char*)g.Bt + (size_t)cur.pn * tstep;
    S.a_ready(cur);
    if constexpr (SP2) {
        PG8_STAGE(PG8_SB(0, 0), cB, voffB); PG8_STAGE(PG8_SB(0, 1), cB + hstep, voffB); PG8_STAGE(PG8_SA(0, 0), cA, voffA); PG8_STAGE(PG8_SA(0, 1), cA + hstep, voffA);
        if (wr == 1) PG8_BAR;
        PG8_WAIT_V(2); PG8_BAR;
        PG8_STAGE(PG8_SB(1, 0), cB + kstep, voffB); PG8_STAGE(PG8_SA(1, 0), cA + kstep, voffA); PG8_STAGE(PG8_SB(1, 1), cB + hstep + kstep, voffB);
        PG8_WAIT_V(6); PG8_BAR;
    } else {
        PG8_STAGE(PG8_SB(0, 0), cB, voffB); PG8_STAGE(PG8_SA(0, 0), cA, voffA); PG8_STAGE(PG8_SB(0, 1), cB + hstep, voffB); PG8_STAGE(PG8_SA(0, 1), cA + hstep, voffA);
        if (wr == 1) PG8_BAR;
        PG8_WAIT_V(4); PG8_BAR;
        PG8_STAGE(PG8_SB(1, 0), cB + kstep, voffB); PG8_STAGE(PG8_SA(1, 0), cA + kstep, voffA); PG8_STAGE(PG8_SB(1, 1), cB + hstep + kstep, voffB);
        PG8_WAIT_V(6); PG8_BAR;
    }
    for (;;) {
        const bool has_next = S.next(ui + 1, nxt);
        const char* nA = has_next ? (const char*)g.A + (size_t)nxt.pm * tstep : cA; const char* nB = has_next ? (const char*)g.Bt + (size_t)nxt.pn * tstep : cB;
        for (int t = 0; t < nt; t += 2) {
            const bool last = (t == nt - 2);
            const char* a1 = cA + (size_t)(t + 1) * kstep;
            const char* a2 = last ? nA : cA + (size_t)(t + 2) * kstep; const char* b2 = last ? nB : cB + (size_t)(t + 2) * kstep;
            const char* a3 = a2 + kstep; const char* b3 = b2 + kstep;
            if (last && has_next) S.a_ready(nxt);
            if constexpr (SP2) {
            PG8_LDB(B0, 0, 0); PG8_LDB(B1, 0, 1); PG8_SCHED; PG8_LDA(At, 0, 0); PG8_STAGE(PG8_SA(1, 1), a1 + hstep, voffA);
            PG8_WAIT_V(8); PG8_WAIT_L(0); PG8_BAR; PG8_MMA(0, 0, At, B0); PG8_MMA(0, 1, At, B1); PG8_BAR; PG8_SCHED;
            PG8_LDA(At, 0, 1); PG8_STAGE(PG8_SB(0, 0), b2, voffB); PG8_STAGE(PG8_SB(0, 1), b2 + hstep, voffB); PG8_STAGE(PG8_SA(0, 0), a2, voffA);
            PG8_WAIT_V(8); PG8_WAIT_L(0); PG8_BAR; PG8_MMA(1, 0, At, B0); PG8_MMA(1, 1, At, B1); PG8_BAR; PG8_SCHED;
            PG8_LDB(B0, 1, 0); PG8_LDB(B1, 1, 1); PG8_SCHED; PG8_LDA(At, 1, 0); PG8_STAGE(PG8_SA(0, 1), a2 + hstep, voffA);
            PG8_WAIT_V(8); PG8_WAIT_L(0); PG8_BAR; PG8_MMA(0, 0, At, B0); PG8_MMA(0, 1, At, B1); PG8_BAR; PG8_SCHED;
            PG8_LDA(At, 1, 1); PG8_STAGE(PG8_SB(1, 0), b3, voffB); PG8_STAGE(PG8_SB(1, 1), b3 + hstep, voffB); PG8_STAGE(PG8_SA(1, 0), a3, voffA);
            PG8_WAIT_V(8); PG8_WAIT_L(0); PG8_BAR; PG8_MMA(1, 0, At, B0); PG8_MMA(1, 1, At, B1); PG8_BAR; PG8_SCHED;
            } else {
            PG8_LDB(B0, 0, 0); PG8_SCHED; PG8_LDA(At, 0, 0); PG8_STAGE(PG8_SA(1, 1), a1 + hstep, voffA);
            PG8_WAIT_L(8); PG8_BAR; PG8_WAIT_L(0); PG8_MMA(0, 0, At, B0); PG8_BAR; PG8_SCHED;
            PG8_LDB(B1, 0, 1); PG8_STAGE(PG8_SB(0, 0), b2, voffB);
            PG8_BAR; PG8_WAIT_L(0); PG8_MMA(0, 1, At, B1); PG8_BAR;
            PG8_LDA(At, 0, 1); PG8_STAGE(PG8_SA(0, 0), a2, voffA);
            PG8_BAR; PG8_WAIT_L(0); PG8_MMA(1, 0, At, B0); PG8_BAR; PG8_SCHED;
            PG8_STAGE(PG8_SB(0, 1), b2 + hstep, voffB);
            PG8_WAIT_V(6); PG8_BAR; PG8_MMA(1, 1, At, B1); PG8_BAR;
            PG8_LDB(B0, 1, 0); PG8_SCHED; PG8_LDA(At, 1, 0); PG8_STAGE(PG8_SA(0, 1), a2 + hstep, voffA);
            PG8_WAIT_L(8); PG8_BAR; PG8_WAIT_L(0); PG8_MMA(0, 0, At, B0); PG8_BAR; PG8_SCHED;
            PG8_LDB(B1, 1, 1); PG8_STAGE(PG8_SB(1, 0), b3, voffB);
            PG8_BAR; PG8_WAIT_L(0); PG8_MMA(0, 1, At, B1); PG8_BAR;
            PG8_LDA(At, 1, 1); PG8_STAGE(PG8_SA(1, 0), a3, voffA);
            PG8_BAR; PG8_WAIT_L(0); PG8_MMA(1, 0, At, B0); PG8_BAR; PG8_SCHED;
            PG8_STAGE(PG8_SB(1, 1), b3 + hstep, voffB);
            PG8_WAIT_V(6); PG8_BAR; PG8_MMA(1, 1, At, B1); PG8_BAR;
            }
        }
        if constexpr (ALIGN_EPI) { if (wr == 0) PG8_BAR; }
        if constexpr (!Epi::AFTER_DRAIN) { E(acc, cur, wr, wc, fr, fq); S.done(cur); }
        if (!has_next) break;
#pragma unroll
        for (int a = 0; a < 2; ++a)
#pragma unroll
            for (int b = 0; b < 2; ++b)
#pragma unroll
                for (int m = 0; m < 4; ++m)
#pragma unroll
                    for (int n = 0; n < 2; ++n) acc[a][b][m][n] = (f32x4){0.f, 0.f, 0.f, 0.f};
        cur = nxt; cA = nA; cB = nB; ++ui;
        if constexpr (ALIGN_EPI) { if (wr == 1) PG8_BAR; }
    }
    PG8_WAIT_V(0);
    if constexpr (!ALIGN_EPI) { if (wr == 0) PG8_BAR; }
    PG8_BAR;
    if constexpr (Epi::AFTER_DRAIN) { E.fused(acc, cur, wr, wc, fr, fq, lds, wid, lane); S.done(cur); }
#undef PG8_SA
#undef PG8_SB
#undef PG8_STAGE
#undef PG8_LDA
#undef PG8_LDB
#undef PG8_MMA
#undef PG8_WAIT_V
#undef PG8_WAIT_L
#undef PG8_BAR
#undef PG8_SCHED
}
#else
template <class Epi, class Sched, bool ALIGN_EPI = false, bool SP2 = false>
inline void gemm_phase(unsigned char*, const Gemm g, const Sched& S, const Epi& E) {
    const int tid = TID(), wid = tid >> 6, lane = tid & 63, wr = wid >> 2, wc = wid & 3, fr = lane & 15, fq = lane >> 4;
    const int K = g.K; Unit u;
    std::vector<float> fa((size_t)8 * K), fb((size_t)16 * K);
    for (int i = 0; S.next(i, u); ++i) {
        for (int ai = 0; ai < 2; ++ai) for (int m = 0; m < 4; ++m) { const int row = 256 * u.pm + 128 * ai + 64 * wr + 16 * m + fr; for (int k = 0; k < K; ++k) fa[(size_t)(ai * 4 + m) * K + k] = bf2f(g.A[(size_t)row * K + k]); }
        for (int bj = 0; bj < 2; ++bj) for (int n = 0; n < 2; ++n) for (int e = 0; e < 4; ++e) { const int col = 256 * u.pn + 128 * bj + 32 * wc + (Epi::PERM ? 8 * fq + 4 * n + e : 16 * n + 4 * fq + e);
            for (int k = 0; k < K; ++k) fb[(size_t)(bj * 8 + n * 4 + e) * K + k] = bf2f(g.Bt[(size_t)col * K + k]); }
        f32x4 acc[2][2][4][2];
        for (int ai = 0; ai < 2; ++ai) for (int bj = 0; bj < 2; ++bj) for (int m = 0; m < 4; ++m) for (int n = 0; n < 2; ++n) for (int e = 0; e < 4; ++e) {
            const float* pa = &fa[(size_t)(ai * 4 + m) * K]; const float* pb = &fb[(size_t)(bj * 8 + n * 4 + e) * K]; float s = 0.f; for (int k = 0; k < K; ++k) s += pa[k] * pb[k]; acc[ai][bj][m][n][e] = s; }
        E(acc, u, wr, wc, fr, fq);
    }
    block_sync();
}
#endif
}
#ifndef EMU
#define LAS __attribute__((address_space(3)))
#define XB_TMO      128
#define XB_XCNT(j)  (256  + 64 * (j))
#define XB_XSUB(j)  (1280 + 64 * (j))
#define XB_XGEN(j)  (2304 + 64 * (j))
#define XB_TOP      3328
#define XB_TOPGEN   3392
#define XCD_BAR_WORDS 3456
#define XB_SPIN_CAP (1u << 18)

__device__ __forceinline__ unsigned xb_ld(unsigned* p)              { return __hip_atomic_load(p, __ATOMIC_RELAXED, __HIP_MEMORY_SCOPE_AGENT); }
__device__ __forceinline__ unsigned xb_add(unsigned* p, unsigned v) { return __hip_atomic_fetch_add(p, v, __ATOMIC_RELAXED, __HIP_MEMORY_SCOPE_AGENT); }
__device__ __forceinline__ unsigned xb_xcc_id() { return (unsigned)__builtin_amdgcn_s_getreg((3 << 11) | 20) & 0xFu; }
#define XB_SPIN(cond, bar) do { unsigned _sp = 0; while (cond) { __builtin_amdgcn_s_sleep(1); \
    if ((++_sp & 255u) == 0u) { if (xb_ld(&(bar)[XB_TMO])) break; if (_sp > XB_SPIN_CAP) { atomicAdd(&(bar)[XB_TMO], 1u); break; } } } } while (0)

struct XcdBarrier {
    unsigned* bar; unsigned x;
    volatile LAS unsigned* st;
};

__device__ __forceinline__ XcdBarrier xcd_barrier_post(unsigned* bar, volatile LAS unsigned* st) {
    XcdBarrier b; b.bar = bar; b.x = xb_xcc_id(); b.st = st;
    if (threadIdx.x == 0) (void)xb_add(&bar[XB_XCNT(b.x)], 1u);
    return b;
}
__device__ __forceinline__ void xcd_barrier_complete(unsigned* bar, unsigned x, unsigned& nloc, unsigned& nx) {
    const unsigned G = gridDim.x * gridDim.y * gridDim.z;
    unsigned sum, cnt, mine, sp = 0u;
    for (;;) {
        sum = 0u; cnt = 0u; mine = 0u;
#pragma unroll
        for (unsigned j = 0; j < 16; ++j) { const unsigned c = xb_ld(&bar[XB_XCNT(j)]); sum += c; cnt += (c > 0u) ? 1u : 0u; mine = (j == x) ? c : mine; }
        if (sum == G) break;
        __builtin_amdgcn_s_sleep(1);
        if ((++sp & 255u) == 0u) { if (xb_ld(&bar[XB_TMO])) break; if (sp > XB_SPIN_CAP) { atomicAdd(&bar[XB_TMO], 1u); break; } }
    }
    nloc = mine > 0u ? mine : 1u; nx = cnt > 0u ? cnt : 1u;
}

__device__ __forceinline__ void xcd_barrier(const XcdBarrier& b) {
    asm volatile("s_waitcnt vmcnt(0)" ::: "memory");
    __syncthreads();
    if (threadIdx.x == 0) {
        unsigned* bar = b.bar;
        __builtin_amdgcn_s_waitcnt(0);
        unsigned nloc = b.st[0], nx = b.st[1];
        if (nloc == 0u) { xcd_barrier_complete(bar, b.x, nloc, nx); b.st[0] = nloc; b.st[1] = nx; }
        const unsigned old = xb_add(&bar[XB_XSUB(b.x)], 1u);
        const unsigned gen = old / nloc;
        if (old + 1u == (gen + 1u) * nloc) {
            __builtin_amdgcn_fence(__ATOMIC_RELEASE, "agent");
            asm volatile("s_waitcnt vmcnt(0)" ::: "memory");
            const unsigned og = xb_add(&bar[XB_TOP], 1u);
            const unsigned tg = og / nx;
            if (og + 1u == (tg + 1u) * nx) xb_add(&bar[XB_TOPGEN], 1u);
            else XB_SPIN(xb_ld(&bar[XB_TOPGEN]) == tg, bar);
            __builtin_amdgcn_fence(__ATOMIC_ACQUIRE, "agent");
            xb_add(&bar[XB_XGEN(b.x)], 1u);
            asm volatile("s_waitcnt vmcnt(0)" ::: "memory");
        } else {
            XB_SPIN(xb_ld(&bar[XB_XGEN(b.x)]) == gen, bar);
            __builtin_amdgcn_fence(__ATOMIC_ACQUIRE, "agent");
            asm volatile("s_waitcnt vmcnt(0)" ::: "memory");
        }
    }
    __syncthreads();
}
#endif
using pg8::Unit;
#ifndef EMU
#define EPI_FENCE() asm volatile("" ::: "memory")
#else
#define EPI_FENCE()
#endif
struct EpiProj {
    static constexpr bool PERM = true, AFTER_DRAIN = false;
    bf16_t* P; float* DT;
    DEV void operator()(const f32x4 (&acc)[2][2][4][2], const Unit& u, int wr, int wc, int fr, int fq) const {
        const int row0 = u.pm * 256 + wr * 64 + fr;
        if (u.pn < PW / 256) {
            const int col0 = u.pn * 256 + wc * 32 + 8 * fq;
#pragma unroll
            for (int ai = 0; ai < 2; ++ai)
#pragma unroll
                for (int m = 0; m < 4; ++m) { bf16_t* rowp = P + (size_t)(row0 + ai * 128 + m * 16) * PWP + col0;
#pragma unroll
                    for (int bj = 0; bj < 2; ++bj) { const f32x4 v0 = acc[ai][bj][m][0], v1 = acc[ai][bj][m][1]; u32x4 w; w.x = pk2(v0[0], v0[1]); w.y = pk2(v0[2], v0[3]); w.z = pk2(v1[0], v1[1]); w.w = pk2(v1[2], v1[3]);
                        *(u32x4*)(rowp + bj * 128) = w; } }
        } else if (wc == 0 && fq < 2) {
#pragma unroll
            for (int ai = 0; ai < 2; ++ai)
#pragma unroll
                for (int m = 0; m < 4; ++m) { float* rowp = DT + (size_t)(row0 + ai * 128 + m * 16) * 16 + 8 * fq; *(f32x4*)rowp = acc[ai][0][m][0]; *(f32x4*)(rowp + 4) = acc[ai][0][m][1]; }
        }
    }
};
template <int MODE> struct EpiBranch {
    static constexpr bool PERM = true, AFTER_DRAIN = false;
    const bf16_t* GATE; float* MIX; bf16_t* MIXB;
    DEV void operator()(const f32x4 (&acc)[2][2][4][2], const Unit& u, int wr, int wc, int fr, int fq) const {
        const int row0 = u.pm * 256 + wr * 64 + fr, col0 = u.pn * 256 + wc * 32 + 8 * fq;
#pragma unroll
        for (int ai = 0; ai < 2; ++ai)
#pragma unroll
            for (int m = 0; m < 4; ++m) { const size_t row = (size_t)(row0 + ai * 128 + m * 16);
#pragma unroll
                for (int bj = 0; bj < 2; ++bj) { const int c = col0 + bj * 128; float g[8]; unpack8(*(const u32x4*)(GATE + row * PWP + c), g);
                    f32x4 v0 = acc[ai][bj][m][0], v1 = acc[ai][bj][m][1];
#pragma unroll
                    for (int i = 0; i < 4; ++i) { v0[i] *= sigm(g[i]); v1[i] *= sigm(g[4 + i]); }
                    bf16_t* mp = MIXB + row * D + c;
                    if (MODE >= 1) { float pv[8]; unpack8(*(const u32x4*)mp, pv); v0 += (f32x4){pv[0], pv[1], pv[2], pv[3]}; v1 += (f32x4){pv[4], pv[5], pv[6], pv[7]}; }
                    { u32x4 w; w.x = pk2(v0[0], v0[1]); w.y = pk2(v0[2], v0[3]); w.z = pk2(v1[0], v1[1]); w.w = pk2(v1[2], v1[3]); *(u32x4*)mp = w; } }
                EPI_FENCE(); }
    }
};
struct EpiResid {
    static constexpr bool PERM = true, AFTER_DRAIN = false;
    const bf16_t* XIN; float* OUT;
    DEV void operator()(const f32x4 (&acc)[2][2][4][2], const Unit& u, int wr, int wc, int fr, int fq) const {
        const int row0 = u.pm * 256 + wr * 64 + fr, col0 = u.pn * 256 + wc * 32 + 8 * fq;
#pragma unroll
        for (int ai = 0; ai < 2; ++ai)
#pragma unroll
            for (int m = 0; m < 4; ++m) { const size_t off = (size_t)(row0 + ai * 128 + m * 16) * D + col0;
#pragma unroll
                for (int bj = 0; bj < 2; ++bj) { float xv[8]; unpack8(*(const u32x4*)(XIN + off + bj * 128), xv);
                    *(f32x4*)(OUT + off + bj * 128) = (f32x4){xv[0], xv[1], xv[2], xv[3]} * DN_ALPHA + acc[ai][bj][m][0]; *(f32x4*)(OUT + off + bj * 128 + 4) = (f32x4){xv[4], xv[5], xv[6], xv[7]} * DN_ALPHA + acc[ai][bj][m][1]; }
                EPI_FENCE(); }
    }
};
struct EpiSwiGLU {
    static constexpr bool PERM = true, AFTER_DRAIN = false;
    bf16_t* H;
    DEV void operator()(const f32x4 (&acc)[2][2][4][2], const Unit& u, int wr, int wc, int fr, int fq) const {
        const int row0 = u.pm * 256 + wr * 64 + fr, col0 = u.pn * 128 + wc * 32 + 8 * fq;
#pragma unroll
        for (int ai = 0; ai < 2; ++ai)
#pragma unroll
            for (int m = 0; m < 4; ++m) { const f32x4 g0 = acc[ai][0][m][0], g1 = acc[ai][0][m][1], u0 = acc[ai][1][m][0], u1 = acc[ai][1][m][1]; u32x4 w;
                w.x = pk2(silu(g0[0]) * u0[0], silu(g0[1]) * u0[1]); w.y = pk2(silu(g0[2]) * u0[2], silu(g0[3]) * u0[3]); w.z = pk2(silu(g1[0]) * u1[0], silu(g1[1]) * u1[1]); w.w = pk2(silu(g1[2]) * u1[2], silu(g1[3]) * u1[3]);
                *(u32x4*)(H + (size_t)(row0 + ai * 128 + m * 16) * DFF + col0) = w; }
    }
};

constexpr int NXR = NMETA + SB, NXB = (NXR + 15) / 16;
template <class F> DEV void skinny_gemm(const bf16_t* A, int K, int nunits, int vcu, int G, const F& f, unsigned char* lds) {
    constexpr int NPA = (NXR * 32 + 511) / 512;
    const int tid = TID_OPAQUE(), lane = tid & 63, w = uniform(tid >> 6), quad = lane >> 4, l15 = lane & 15;
    bf16_t* As = (bf16_t*)lds; bf16_t* Bs = (bf16_t*)(lds + NXR * 264 * 2);
    const bool own = 16 * w < NXR && w < 8, ext = NXB > 8 && w < 2;
    const int nkc = K / 256;
    for (int u = vcu; u < nunits; u += G) {
        f32x4 acc[4], acc8[2];
#pragma unroll
        for (int cb = 0; cb < 4; ++cb) acc[cb] = (f32x4){0.f, 0.f, 0.f, 0.f};
        acc8[0] = acc8[1] = (f32x4){0.f, 0.f, 0.f, 0.f};
        u32x4 ra[NPA], rb[4]; const bf16_t* pbs[4];
#pragma unroll
        for (int j = 0; j < 4; ++j) { const int id = tid + 512 * j, br = id >> 5; pbs[j] = f.brow(u, br >> 4) + (size_t)(br & 15) * K + 8 * (id & 31); }
#define SK_FETCH(kc) do { _Pragma("unroll") for (int j = 0; j < NPA; ++j) { const int id = tid + 512 * j, row = id >> 5; if (row < NXR) ra[j] = *(const u32x4*)(A + (size_t)row * K + 256 * (kc) + 8 * (id & 31)); } \
        _Pragma("unroll") for (int j = 0; j < 4; ++j) rb[j] = *(const u32x4*)(pbs[j] + 256 * (kc)); } while (0)
#define SK_STORE() do { _Pragma("unroll") for (int j = 0; j < NPA; ++j) { const int id = tid + 512 * j, row = id >> 5; if (row < NXR) *(u32x4*)(As + row * 264 + 8 * (id & 31)) = ra[j]; } \
        _Pragma("unroll") for (int j = 0; j < 4; ++j) { const int id = tid + 512 * j; *(u32x4*)(Bs + (id >> 5) * 264 + 8 * (id & 31)) = rb[j]; } } while (0)
        SK_FETCH(0); SK_STORE();
        lds_barrier();
        for (int kc = 0; kc < nkc; ++kc) {
            if (kc + 1 < nkc) SK_FETCH(kc + 1);
            if (own) {
#pragma unroll
                for (int kk = 0; kk < 8; ++kk) { const bf16x8 a = frag(As, 264, 16 * w + l15, 32 * kk + 8 * quad); bf16x8 bfr[4];
#pragma unroll
                    for (int cb = 0; cb < 4; ++cb) { bfr[cb] = frag(Bs, 264, 16 * cb + l15, 32 * kk + 8 * quad); acc[cb] = mfma16(bfr[cb], a, acc[cb]); }
                    if (ext) { const bf16x8 a8 = frag(As, 264, 128 + l15, 32 * kk + 8 * quad); acc8[0] = mfma16(w == 0 ? bfr[0] : bfr[1], a8, acc8[0]); acc8[1] = mfma16(w == 0 ? bfr[2] : bfr[3], a8, acc8[1]); } } }
            lds_barrier();
            if (kc + 1 < nkc) SK_STORE();
            lds_barrier();
        }
#undef SK_FETCH
#undef SK_STORE
        if (own && 16 * w + l15 < NXR) { f.epi(u, RP + 16 * w + l15, quad, 0, acc[0], acc[2]); f.epi(u, RP + 16 * w + l15, quad, 1, acc[1], acc[3]); }
        if (ext && 128 + l15 < NXR) f.epi(u, RP + 128 + l15, quad, w, acc8[0], acc8[1]);
    }
}
DEV void dt_gemm(const bf16_t* A, const bf16_t* Wdt, float* DT, int vcu, int G) {
    const int tid = TID_OPAQUE(), lane = tid & 63, w = uniform(tid >> 6), quad = lane >> 4, l15 = lane & 15;
    if (w >= 4) return;
    for (int u = vcu; u < RP / 64; u += G) { const int row = 64 * u + 16 * w + l15; const bf16_t* pa = A + (size_t)row * 1024 + 8 * quad; const bf16_t* pb = Wdt + (size_t)l15 * 1024 + 8 * quad; f32x4 acc = {0.f, 0.f, 0.f, 0.f};
#pragma unroll 8
        for (int kk = 0; kk < 32; ++kk) acc = mfma16(*(const bf16x8*)(pb + 32 * kk), *(const bf16x8*)(pa + 32 * kk), acc);
        *(f32x4*)(DT + (size_t)row * 16 + 4 * quad) = acc; }
}
struct SkProj {
    const bf16_t* W; bf16_t* P; float* DT;
    DEV const bf16_t* brow(int u, int cb) const { return W + (size_t)(u < 256 ? 64 * u + 16 * cb : PW) * 1024; }
    DEV void epi(int u, int row, int quad, int cb, f32x4 va, f32x4 vb) const {
        if (u < 256) { bf16_t* p = P + (size_t)row * PWP + 64 * u + 16 * cb + 4 * quad; *(u32x2*)p = pk4(va); *(u32x2*)(p + 32) = pk4(vb); }
        else if (cb == 0) *(f32x4*)(DT + (size_t)row * 16 + 4 * quad) = va; }
};
template <int MODE> struct SkBranch {
    const bf16_t* W; int K; const bf16_t* GATE; float* MIX; bf16_t* MIXB;
    DEV const bf16_t* brow(int u, int cb) const { return W + (size_t)(64 * u + 16 * cb) * K; }
    DEV void one(int row, int c, f32x4 v) const { const u32x2 gw = *(const u32x2*)(GATE + (size_t)row * PWP + c);
        v[0] *= sigm(u2f(gw.x << 16)); v[1] *= sigm(u2f(gw.x & 0xffff0000u)); v[2] *= sigm(u2f(gw.y << 16)); v[3] *= sigm(u2f(gw.y & 0xffff0000u));
        bf16_t* mp = MIXB + (size_t)row * D + c; if (MODE >= 1) { const u32x2 pw = *(const u32x2*)mp; v += (f32x4){u2f(pw.x << 16), u2f(pw.x & 0xffff0000u), u2f(pw.y << 16), u2f(pw.y & 0xffff0000u)}; } *(u32x2*)mp = pk4(v); }
    DEV void epi(int u, int row, int quad, int cb, f32x4 va, f32x4 vb) const { one(row, 64 * u + 16 * cb + 4 * quad, va); one(row, 64 * u + 16 * cb + 32 + 4 * quad, vb); }
};
struct SkResid { const bf16_t* W; int K; const bf16_t* XIN; float* OUT;
    DEV const bf16_t* brow(int u, int cb) const { return W + (size_t)(64 * u + 16 * cb) * K; }
    DEV void one(size_t o, f32x4 v) const { const u32x2 xw = *(const u32x2*)(XIN + o); *(f32x4*)(OUT + o) = (f32x4){u2f(xw.x << 16), u2f(xw.x & 0xffff0000u), u2f(xw.y << 16), u2f(xw.y & 0xffff0000u)} * DN_ALPHA + v; }
    DEV void epi(int u, int row, int quad, int cb, f32x4 va, f32x4 vb) const { const size_t o = (size_t)row * D + 64 * u + 16 * cb + 4 * quad; one(o, va); one(o + 32, vb); }
};
struct SkSwiGLU { const bf16_t* W; bf16_t* H;
    DEV const bf16_t* brow(int u, int cb) const { const int oc = 32 * u + 16 * (cb & 1); return W + (size_t)(256 * (oc / 128) + (oc % 128) + 128 * (cb >> 1)) * 1024; }
    DEV void epi(int u, int row, int quad, int cb, f32x4 g, f32x4 uu) const { f32x4 o; o[0] = silu(g[0]) * uu[0]; o[1] = silu(g[1]) * uu[1]; o[2] = silu(g[2]) * uu[2]; o[3] = silu(g[3]) * uu[3];
        *(u32x2*)(H + (size_t)row * DFF + 32 * u + 16 * cb + 4 * quad) = pk4(o); }
};
struct Frame {
    unsigned char* lds; int tid, lane, wave, vcu, G;
    const float* const* in; float* out; unsigned char* ws; unsigned* ctl;
};
enum { I_XP = 0, I_XS, I_SSM, I_CONV, I_HGRN, I_RET, I_META, I_LNG, I_LNB, I_WIN, I_CONVW, I_CONVB, I_DTB, I_ALOG, I_DSKIP, I_MNW, I_LBL, I_HNW, I_WBM, I_WBH, I_WBR, I_WOUT, I_LN1G, I_LN1B, I_WFI, I_WFO, I_LN2G, I_LN2B };

DEV void transpose_item(const float* W, int Nsrc, int K, bf16_t* WT, int kb, int n0, int sc0, int nvalid, float* scr, int lane) {
    const int k0 = 64 * kb;
    float v[32];
#pragma unroll
    for (int i = 0; i < 32; ++i) { const int kk = 2 * i + (lane >> 5), nn = lane & 31; v[i] = nn < nvalid ? W[(size_t)(k0 + kk) * Nsrc + sc0 + nn] : 0.f; }
#pragma unroll
    for (int i = 0; i < 32; ++i) scr[(2 * i + (lane >> 5)) * 33 + (lane & 31)] = v[i];
    wave_sync();
    const int c = lane & 7;
#pragma unroll
    for (int j = 0; j < 4; ++j) { const int n = (lane >> 3) + 8 * j; const float* s = scr + (8 * c) * 33 + n;
        u32x4 o; o.x = pk2(s[0 * 33], s[1 * 33]); o.y = pk2(s[2 * 33], s[3 * 33]); o.z = pk2(s[4 * 33], s[5 * 33]); o.w = pk2(s[6 * 33], s[7 * 33]);
        *(u32x4*)(WT + (size_t)(n0 + n) * K + k0 + 8 * c) = o; }
    wave_sync();
}
DEV void ln_row(const float* src, const float* g, const float* b, float* dst32, bf16_t* dstbf, int lane) {
    f32x4 v[4]; float s = 0.f;
#pragma unroll
    for (int j = 0; j < 4; ++j) { v[j] = ((const f32x4*)src)[lane + 64 * j]; s += (v[j][0] + v[j][1]) + (v[j][2] + v[j][3]); }
    const float mean = wave_sum(s) * (1.f / D); float q = 0.f;
#pragma unroll
    for (int j = 0; j < 4; ++j) { v[j] = v[j] - mean; q += (v[j][0] * v[j][0] + v[j][1] * v[j][1]) + (v[j][2] * v[j][2] + v[j][3] * v[j][3]); }
    const float rstd = 1.f / sqrtf(wave_sum(q) * (1.f / D) + LN_EPS);
#pragma unroll
    for (int j = 0; j < 4; ++j) { const f32x4 gg = ((const f32x4*)g)[lane + 64 * j], bb = ((const f32x4*)b)[lane + 64 * j]; const f32x4 o = v[j] * rstd * gg + bb;
        if (dst32) ((f32x4*)dst32)[lane + 64 * j] = o;
        if (dstbf) { u32x2 w; w.x = pk2(o[0], o[1]); w.y = pk2(o[2], o[3]); ((u32x2*)dstbf)[lane + 64 * j] = w; } }
}
DEV void p0_prologue(const Frame& F) {
    float* scr = (float*)(F.lds + F.wave * 16384);
    const int gw = F.vcu * 8 + F.wave, NGW = F.G * 8;
    constexpr int I_W1 = 16 * (N1 / 32), I_SQ = 16 * 32, I_R = 32 * 32, I_FI = 16 * (2 * DFF / 32), I_FO = (DFF / 64) * 32, I_LAYER = I_W1 + 3 * I_SQ + I_R + I_FI + I_FO;
    for (int it = gw; it < DEPTH * I_LAYER; it += NGW) {
        const int l = it / I_LAYER; int r = it % I_LAYER;
        if (r < I_W1) { const int nb = r % (N1 / 32), kb = r / (N1 / 32), n0 = 32 * nb; int sc0 = n0, nv = 32; if (n0 >= 3072 && n0 < PW) sc0 = n0 + 16; else if (n0 == PW) { sc0 = 3072; nv = 16; } else if (n0 > PW) { sc0 = 0; nv = 0; }
            transpose_item(F.in[I_WIN] + (size_t)l * 1024 * IN_DIM, IN_DIM, 1024, (bf16_t*)(F.ws + WS_W1T + l * SZ_W1T), kb, n0, sc0, nv, scr, F.lane); continue; } r -= I_W1;
        if (r < I_SQ) { transpose_item(F.in[I_WBM] + (size_t)l * 1024 * 1024, 1024, 1024, (bf16_t*)(F.ws + WS_WMT + l * SZ_WSQ), r / 32, 32 * (r % 32), 32 * (r % 32), 32, scr, F.lane); continue; } r -= I_SQ;
        if (r < I_SQ) { transpose_item(F.in[I_WBH] + (size_t)l * 1024 * 1024, 1024, 1024, (bf16_t*)(F.ws + WS_WHT + l * SZ_WSQ), r / 32, 32 * (r % 32), 32 * (r % 32), 32, scr, F.lane); continue; } r -= I_SQ;
        if (r < I_R) { transpose_item(F.in[I_WBR] + (size_t)l * 2048 * 1024, 1024, 2048, (bf16_t*)(F.ws + WS_WRT + l * SZ_WRT), r / 32, 32 * (r % 32), 32 * (r % 32), 32, scr, F.lane); continue; } r -= I_R;
        if (r < I_SQ) { transpose_item(F.in[I_WOUT] + (size_t)l * 1024 * 1024, 1024, 1024, (bf16_t*)(F.ws + WS_WOT + l * SZ_WSQ), r / 32, 32 * (r % 32), 32 * (r % 32), 32, scr, F.lane); continue; } r -= I_SQ;
        if (r < I_FI) { const int nb = r % (2 * DFF / 32), kb = r / (2 * DFF / 32), n0 = 32 * nb, tile = n0 / 256, within = n0 % 256; const int sc0 = within < 128 ? 128 * tile + within : DFF + 128 * tile + (within - 128);
            transpose_item(F.in[I_WFI] + (size_t)l * 1024 * 2 * DFF, 2 * DFF, 1024, (bf16_t*)(F.ws + WS_WFIT + l * SZ_WFIT), kb, n0, sc0, 32, scr, F.lane); continue; } r -= I_FI;
        transpose_item(F.in[I_WFO] + (size_t)l * DFF * 1024, 1024, DFF, (bf16_t*)(F.ws + WS_WFOT + l * SZ_WFOT), r / 32, 32 * (r % 32), 32 * (r % 32), 32, scr, F.lane);
    }
    bf16_t* XN = (bf16_t*)(F.ws + WS_XN);
    for (int r = gw; r < R; r += NGW) {
        if (r >= R_USED) { for (int j = 0; j < 4; ++j) ((u32x2*)(XN + (size_t)r * D))[F.lane + 64 * j] = (u32x2){0u, 0u}; continue; }
        const float* src = r < RP ? F.in[I_XP] + (size_t)r * D : (r < ROW_SMP ? F.in[I_META] + (size_t)(r - ROW_META) * D : F.in[I_XS] + (size_t)(r - ROW_SMP) * D);
        ln_row(src, F.in[I_LNG], F.in[I_LNB], nullptr, XN + (size_t)r * D, F.lane);
    }
    float* rope = (float*)(F.ws + WS_ROPE);
    for (int i = F.vcu * 512 + F.tid; i < ROPE_ROWS * 128; i += F.G * 512) { const int p = i >> 7, f = i & 127; const float pos = (float)(p < SEQ + NMETA ? p : PAST);
        const float inv = 1.0f / powf(10000.0f, (float)f * (1.0f / 127.0f)); const float ang = pos * inv; rope[p * 256 + f] = cosf(ang); rope[p * 256 + 128 + f] = sinf(ang); }
    float* LB = (float*)(F.ws + WS_LB);
    for (int i = F.vcu * 512 + F.tid; i < 1024; i += F.G * 512) { LB[i] = 0.f; LB[1024 + i] = 1.f / (1.f + expf(F.in[I_LBL][i] - F.in[I_LBL][1024 + i])); }
}

DEV void ln_pass(const Frame& F, const float* g, const float* b, bool last) {
    const int gw = F.vcu * 8 + F.wave, NGW = F.G * 8; const float* XPRE = (const float*)(F.ws + WS_XPRE); bf16_t* XN = (bf16_t*)(F.ws + WS_XN);
    for (int r = gw; r < R_USED; r += NGW) {
        if (!last) ln_row(XPRE + (size_t)r * D, g, b, nullptr, XN + (size_t)r * D, F.lane);
        else if (r < RP) ln_row(XPRE + (size_t)r * D, g, b, F.out + O_YP + (size_t)r * D, nullptr, F.lane);
        else if (r >= ROW_SMP) ln_row(XPRE + (size_t)r * D, g, b, F.out + O_YS + (size_t)(r - ROW_SMP) * D, nullptr, F.lane);
    }
}
struct Mix {
    unsigned char* ws; float* out; const float* const* in; int l;
    DEV bf16_t* PROJ() const { return (bf16_t*)(ws + WS_PROJ); }  DEV const float* DT() const { return (const float*)(ws + WS_DT); }
    DEV bf16_t* YM() const { return (bf16_t*)(ws + WS_YM); }  DEV bf16_t* YH() const { return (bf16_t*)(ws + WS_YH); }  DEV bf16_t* YR() const { return (bf16_t*)(ws + WS_YR); }
    DEV float* SSQM() const { return (float*)(ws + WS_SSQM); }  DEV float* SSQH() const { return (float*)(ws + WS_SSQH); }  DEV float* SSQR() const { return (float*)(ws + WS_SSQR); }
    DEV const float* rope() const { return (const float*)(ws + WS_ROPE); }  DEV const float* lb() const { return (const float*)(ws + WS_LB) + l * 1024; }
    DEV const float* conv_w() const { return in[I_CONVW] + (size_t)l * 4 * 2048; }  DEV const float* conv_b() const { return in[I_CONVB] + (size_t)l * 2048; }
    DEV const float* dt_bias() const { return in[I_DTB] + l * 16; }  DEV const float* a_log() const { return in[I_ALOG] + l * 16; }  DEV const float* d_skip() const { return in[I_DSKIP] + l * 16; }
    DEV const float* ssm_in() const { return in[I_SSM] + l * SZ_SSMS; }  DEV const float* conv_in() const { return in[I_CONV] + l * SZ_CONVS; }  DEV const float* hgrn_in() const { return in[I_HGRN] + l * SZ_HGS; }  DEV const float* ret_in() const { return in[I_RET] + l * SZ_RETS; }
    DEV float* ssm_p() const { return out + O_SSMP + l * SZ_SSMP; }  DEV float* conv_p() const { return out + O_CONVP + l * SZ_CONVP; }  DEV float* hgrn_p() const { return out + O_HGP + l * SZ_HGP; }  DEV float* ret_p() const { return out + O_RETP + l * SZ_RETP; }
    DEV float* ssm_s() const { return out + O_SSMS + l * SZ_SSMS; }  DEV float* conv_s() const { return out + O_CONVS + l * SZ_CONVS; }  DEV float* hgrn_s() const { return out + O_HGS + l * SZ_HGS; }  DEV float* ret_s() const { return out + O_RETS + l * SZ_RETS; }
    DEV bf16_t* XC() const { return (bf16_t*)(ws + WS_XC); }  DEV bf16_t* BC() const { return (bf16_t*)(ws + WS_BC); }  DEV bf16_t* CC() const { return (bf16_t*)(ws + WS_CC); }  DEV bf16_t* XW() const { return (bf16_t*)(ws + WS_XW); }
    DEV float* HDEC() const { return (float*)(ws + WS_HDEC); }  DEV float* ECUM() const { return (float*)(ws + WS_ECUM); }  DEV float* MDEC() const { return (float*)(ws + WS_MDEC); }
};
DEV void chunk_geo(int b, int c, int& row0, int& nv, int& pos0) { if (c == 0) { row0 = ROW_META; nv = NMETA; pos0 = 0; } else { row0 = b * SEQ + (c - 1) * 32; nv = 32; pos0 = NMETA + (c - 1) * 32; } }
DEV void ci_geo(int ci, int& b, int& row0, int& nv, int& pos0) { if (ci == NB * NCH) { b = 0; row0 = ROW_META; nv = NMETA; pos0 = 0; } else { b = ci / NCH; const int cc = ci % NCH; row0 = b * SEQ + cc * 32; nv = 32; pos0 = NMETA + cc * 32; } }
DEV int ci_of(int b, int c) { return c == 0 ? NB * NCH : b * NCH + (c - 1); }
DEV float log_gamma(int h) { return log1pf(-exp2f(-5.0f - (float)h)); }

struct RetRaw { u32x4 q1, q2, k1, k2, v[4]; f32x4 c0, c1, s0, s1; };
DEV void retA_fetch(const Mix& M, int h, int ci, int tid, RetRaw& r) {
    int b, row0, nv, pos0; ci_geo(ci, b, row0, nv, pos0); (void)b; const int srow = tid >> 4, sseg = tid & 15; const u32x4 z = {0u, 0u, 0u, 0u};
    r.q1 = r.q2 = r.k1 = r.k2 = z; r.c0 = r.c1 = r.s0 = r.s1 = (f32x4){0.f, 0.f, 0.f, 0.f};
    if (srow < nv) { const bf16_t* pr = M.PROJ() + (size_t)(row0 + srow) * PWP; const float* rp = M.rope() + (size_t)(pos0 + srow) * 256 + 8 * sseg;
        r.c0 = *(const f32x4*)rp; r.c1 = *(const f32x4*)(rp + 4); r.s0 = *(const f32x4*)(rp + 128); r.s1 = *(const f32x4*)(rp + 132);
        r.q1 = *(const u32x4*)(pr + C_RQ + 256 * h + 8 * sseg); r.q2 = *(const u32x4*)(pr + C_RQ + 256 * h + 128 + 8 * sseg); r.k1 = *(const u32x4*)(pr + C_RK + 256 * h + 8 * sseg); r.k2 = *(const u32x4*)(pr + C_RK + 256 * h + 128 + 8 * sseg); }
#pragma unroll
    for (int j = 0; j < 4; ++j) { const int id = tid + 512 * j, row = id >> 6, seg = id & 63; r.v[j] = row < nv ? *(const u32x4*)(M.PROJ() + (size_t)(row0 + row) * PWP + C_RV + 512 * h + 8 * seg) : z; }
}
DEV void retA_unit(const Mix& M, unsigned char* lds, int h, int ci, RetRaw& r, int ci_next) {
    const int tid = TID_OPAQUE(), lane = tid & 63, w = uniform(tid >> 6), quad = lane >> 4, l15 = lane & 15;
    bf16_t* Qn = (bf16_t*)(lds); bf16_t* Kd = (bf16_t*)(lds + 16896); bf16_t* Vn = (bf16_t*)(lds + 33792); bf16_t* Pl = (bf16_t*)(lds + 67072);
    int b, row0, nv, pos0; ci_geo(ci, b, row0, nv, pos0); (void)b; (void)pos0;
    const float lg = log_gamma(h); const int srow = tid >> 4, sseg = tid & 15;
    {   float q1[8], q2[8], k1[8], k2[8];
        if (srow < nv) { bf16_t* pr = M.PROJ() + (size_t)(row0 + srow) * PWP; float a1[8], a2[8]; const float kd = fexp((float)(nv - 1 - srow) * lg) * 0.0625f, qg = fexp((float)(srow + 1) * lg);
            const float cs[8] = {r.c0[0], r.c0[1], r.c0[2], r.c0[3], r.c1[0], r.c1[1], r.c1[2], r.c1[3]}, sn[8] = {r.s0[0], r.s0[1], r.s0[2], r.s0[3], r.s1[0], r.s1[1], r.s1[2], r.s1[3]};
            unpack8(r.q1, a1); unpack8(r.q2, a2);
#pragma unroll
            for (int i = 0; i < 8; ++i) { q1[i] = a1[i] * cs[i] - a2[i] * sn[i]; q2[i] = a2[i] * cs[i] + a1[i] * sn[i]; }
            unpack8(r.k1, a1); unpack8(r.k2, a2);
#pragma unroll
            for (int i = 0; i < 8; ++i) { k1[i] = (a1[i] * cs[i] - a2[i] * sn[i]) * kd; k2[i] = (a2[i] * cs[i] + a1[i] * sn[i]) * kd; }
            const u32x4 kp1 = pack8(k1), kp2 = pack8(k2);
            *(u32x4*)(Kd + srow * 264 + 8 * sseg) = kp1; *(u32x4*)(Kd + srow * 264 + 128 + 8 * sseg) = kp2;
            *(u32x4*)(pr + C_RK + 256 * h + 8 * sseg) = kp1; *(u32x4*)(pr + C_RK + 256 * h + 128 + 8 * sseg) = kp2;
            *(u32x4*)(Qn + srow * 264 + 8 * sseg) = pack8(q1); *(u32x4*)(Qn + srow * 264 + 128 + 8 * sseg) = pack8(q2);
#pragma unroll
            for (int i = 0; i < 8; ++i) { q1[i] *= qg; q2[i] *= qg; }
            *(u32x4*)(pr + C_RQ + 256 * h + 8 * sseg) = pack8(q1); *(u32x4*)(pr + C_RQ + 256 * h + 128 + 8 * sseg) = pack8(q2);
        } else { const u32x4 z = {0u, 0u, 0u, 0u}; *(u32x4*)(Kd + srow * 264 + 8 * sseg) = z; *(u32x4*)(Kd + srow * 264 + 128 + 8 * sseg) = z; *(u32x4*)(Qn + srow * 264 + 8 * sseg) = z; *(u32x4*)(Qn + srow * 264 + 128 + 8 * sseg) = z; }
#pragma unroll
        for (int j = 0; j < 4; ++j) { const int id = tid + 512 * j, row = id >> 6, seg = id & 63; *(u32x4*)(Vn + row * 520 + 8 * seg) = r.v[j]; }
    }
    if (ci_next >= 0) retA_fetch(M, h, ci_next, tid, r);
    lds_barrier();
    if (w < 3) { const int tb = w > 0, sb = w > 1; f32x4 P = {0.f, 0.f, 0.f, 0.f};
#pragma unroll
        for (int kk = 0; kk < 8; ++kk) P = mfma16(frag(Kd, 264, 16 * sb + l15, 32 * kk + 8 * quad), frag(Qn, 264, 16 * tb + l15, 32 * kk + 8 * quad), P);
        const int t = 16 * tb + l15; const float rs = fexp((float)(t + 1 - nv) * lg);
#pragma unroll
        for (int e = 0; e < 4; ++e) P[e] = (16 * sb + 4 * quad + e <= t) ? P[e] * rs : 0.f;
        *(u32x2*)(Pl + t * 40 + 16 * sb + 4 * quad) = pk4(P);
    } else if (w == 3) *(u32x2*)(Pl + l15 * 40 + 16 + 4 * quad) = (u32x2){0u, 0u};
    lds_barrier();
#pragma unroll
    for (int vb = 0; vb < 4; ++vb) { const int vc = 64 * w + 16 * vb; const bf16x8 a = trn(Vn, 520, 0, vc, lane);
#pragma unroll
        for (int tb = 0; tb < 2; ++tb) { const int t = 16 * tb + l15; const f32x4 O = mfma16(a, frag(Pl, 40, t, 8 * quad), (f32x4){0.f, 0.f, 0.f, 0.f});
            if (t < nv) *(u32x2*)(M.YR() + (size_t)(row0 + t) * 2048 + 512 * h + vc + 4 * quad) = pk4(O); } }
    lds_barrier();
}

struct HgRaw { u32x4 q, f, v; };
DEV void hgrnA_fetch(const Mix& M, int h, int ci, int tid, HgRaw& r) {
    int b, row0, nv, pos0; ci_geo(ci, b, row0, nv, pos0); (void)b; (void)pos0; const int srow = tid >> 4, sseg = tid & 15; const u32x4 z = {0u, 0u, 0u, 0u}; r.q = r.f = r.v = z;
    if (srow < nv) { const bf16_t* pr = M.PROJ() + (size_t)(row0 + srow) * PWP; r.q = *(const u32x4*)(pr + C_HQ + 128 * h + 8 * sseg); r.f = *(const u32x4*)(pr + C_HF + 128 * h + 8 * sseg); r.v = *(const u32x4*)(pr + C_HI + 128 * h + 8 * sseg); }
}
DEV void hgrnA_unit(const Mix& M, unsigned char* lds, int h, int ci, HgRaw& r, int ci_next) {
    const int tid = TID_OPAQUE(), lane = tid & 63, w = uniform(tid >> 6), quad = lane >> 4, l15 = lane & 15;
    float* CUM = (float*)lds; bf16_t* Qd = (bf16_t*)(lds + 16384); bf16_t* Kd = (bf16_t*)(lds + 25088); bf16_t* Vn = (bf16_t*)(lds + 33792); bf16_t* Pl = (bf16_t*)(lds + 42496);
    int b, row0, nv, pos0; ci_geo(ci, b, row0, nv, pos0); (void)b; (void)pos0;
    const int srow = tid >> 4, sseg = tid & 15;
    float q[8], kk8[8];
    {   float fz[8];
        if (srow < nv) { unpack8(r.q, q); unpack8(r.f, fz);
#pragma unroll
            for (int i = 0; i < 8; ++i) { const float lbv = M.lb()[128 * h + 8 * sseg + i], z = fz[i], ez = fexp(-fabsf(z)), ls = fminf(z, 0.f) - flog(1.f + ez);
                float lf = ls; if (lbv > 0.f) { const float a = flog(lbv), bb = flog(1.f - lbv) + ls; lf = fmaxf(a, bb) + flog(1.f + fexp(-fabsf(a - bb))); }
                const float sneg = (z >= 0.f ? ez : 1.f) * frcp(1.f + ez);
                CUM[srow * 128 + 8 * sseg + i] = lf; kk8[i] = (1.f - lbv) * sneg; q[i] *= 0.08838834764831845f; }
        } else {
#pragma unroll
            for (int i = 0; i < 8; ++i) { CUM[srow * 128 + 8 * sseg + i] = 0.f; q[i] = 0.f; kk8[i] = 0.f; } }
        *(u32x4*)(Vn + srow * 136 + 8 * sseg) = r.v;
    }
    if (ci_next >= 0) hgrnA_fetch(M, h, ci_next, tid, r);
    lds_barrier();
    if (tid < 128) { float v[32];
#pragma unroll
        for (int t = 0; t < 32; ++t) v[t] = CUM[t * 128 + tid];
        float a = 0.f;
#pragma unroll
        for (int t = 0; t < 32; ++t) { a += v[t]; CUM[t * 128 + tid] = a; } }
    lds_barrier();
    {   float qd[8], kd[8], qs[8], ks[8];
#pragma unroll
        for (int i = 0; i < 8; ++i) { const int ch = 8 * sseg + i; const float ct = CUM[srow * 128 + ch], cm = CUM[15 * 128 + ch], cl = CUM[31 * 128 + ch];
            qd[i] = q[i] * fexp(ct - cm); kd[i] = kk8[i] * fexp(cm - ct); qs[i] = q[i] * fexp(ct); ks[i] = kk8[i] * fexp(cl - ct);
            if (srow == 31) M.HDEC()[((size_t)ci * 8 + h) * 128 + ch] = fexp(cl); }
        *(u32x4*)(Qd + srow * 136 + 8 * sseg) = pack8(qd); *(u32x4*)(Kd + srow * 136 + 8 * sseg) = pack8(kd);
        if (srow < nv) { bf16_t* pr = M.PROJ() + (size_t)(row0 + srow) * PWP; *(u32x4*)(pr + C_HQ + 128 * h + 8 * sseg) = pack8(qs); *(u32x4*)(pr + C_HF + 128 * h + 8 * sseg) = pack8(ks); }
    }
    lds_barrier();
    if (w < 3) { const int tb = w > 0, sb = w > 1; f32x4 P = {0.f, 0.f, 0.f, 0.f};
#pragma unroll
        for (int kk = 0; kk < 4; ++kk) P = mfma16(frag(Kd, 136, 16 * sb + l15, 32 * kk + 8 * quad), frag(Qd, 136, 16 * tb + l15, 32 * kk + 8 * quad), P);
        const int t = 16 * tb + l15;
#pragma unroll
        for (int e = 0; e < 4; ++e) P[e] = (16 * sb + 4 * quad + e <= t) ? P[e] : 0.f;
        *(u32x2*)(Pl + t * 40 + 16 * sb + 4 * quad) = pk4(P);
    } else if (w == 3) *(u32x2*)(Pl + l15 * 40 + 16 + 4 * quad) = (u32x2){0u, 0u};
    lds_barrier();
    { const bf16x8 a = trn(Vn, 136, 0, 16 * w, lane);
#pragma unroll
      for (int tb = 0; tb < 2; ++tb) { const int t = 16 * tb + l15; const f32x4 O = mfma16(a, frag(Pl, 40, t, 8 * quad), (f32x4){0.f, 0.f, 0.f, 0.f});
          if (t < nv) *(u32x2*)(M.YH() + (size_t)(row0 + t) * 1024 + 128 * h + 16 * w + 4 * quad) = pk4(O); } }
    lds_barrier();
}

struct MbRaw { u32x4 x[5]; float dtr; };
DEV void mambaA_fetch(const Mix& M, int g, int ci, int tid, MbRaw& r) {
    int b, row0, nv, pos0; ci_geo(ci, b, row0, nv, pos0); const int seg = tid & 63;
    const int chan = seg < 32 ? 256 * g + 8 * seg : (seg < 48 ? 1024 + 128 * g + 8 * (seg - 32) : 1536 + 128 * g + 8 * (seg - 48));
#pragma unroll
    for (int j = 0; j < 5; ++j) { const int rr = (tid >> 6) + 8 * j, row = rr - 3, pos = pos0 + row; r.x[j] = (u32x4){0u, 0u, 0u, 0u};
        if (rr < 35 && pos >= 0 && row < nv) { const int gr = pos < NMETA ? ROW_META + pos : b * SEQ + pos - NMETA; r.x[j] = *(const u32x4*)(M.PROJ() + (size_t)gr * PWP + C_X + chan); } }
    r.dtr = 0.f; if (tid < 128 && (tid & 31) < nv) r.dtr = M.DT()[(size_t)(row0 + (tid & 31)) * 16 + 4 * g + (tid >> 5)];
}
DEV void mambaA_cw(const Mix& M, unsigned char* lds, int g) {
    float* CW = (float*)(lds + 36400); const int lc = TID_OPAQUE(); const int chn = lc < 256 ? 256 * g + lc : (lc < 384 ? 1024 + 128 * g + (lc - 256) : 1536 + 128 * g + (lc - 384));
#pragma unroll
    for (int k = 0; k < 4; ++k) CW[k * 512 + lc] = M.conv_w()[k * 2048 + chn];
    CW[4 * 512 + lc] = M.conv_b()[chn];
}
DEV void mambaA_unit(const Mix& M, unsigned char* lds, int g, int ci, MbRaw& r, int ci_next) {
    const int tid = TID_OPAQUE(), lane = tid & 63, w = uniform(tid >> 6), quad = lane >> 4, l15 = lane & 15;
    bf16_t* RAW = (bf16_t*)lds;
    float* CW = (float*)(lds + 36400);
    bf16_t* Xn = (bf16_t*)(lds + 46640); bf16_t* Bn = (bf16_t*)(lds + 63536); bf16_t* Cn = (bf16_t*)(lds + 72240);
    float* DTs = (float*)(lds + 80944); float* CUMs = (float*)(lds + 81456); float* CBl = (float*)(lds + 81968); bf16_t* Wl = (bf16_t*)(lds + 86576);
    int b, row0, nv, pos0; ci_geo(ci, b, row0, nv, pos0); (void)pos0;
    const bool lastc = ci != NB * NCH && (ci % NCH) == NCH - 1;
    const int seg = lane;
    const int chan = seg < 32 ? 256 * g + 8 * seg : (seg < 48 ? 1024 + 128 * g + 8 * (seg - 32) : 1536 + 128 * g + 8 * (seg - 48));
#pragma unroll
    for (int j = 0; j < 5; ++j) { const int rr = (tid >> 6) + 8 * j;
        if (rr < 35) { const int row = rr - 3; *(u32x4*)(RAW + rr * 520 + 8 * seg) = r.x[j];
            if (lastc && row >= 29) { float xv[8]; unpack8(r.x[j], xv); float* cp = M.conv_p() + ((size_t)b * 3 + (row - 29)) * 2048 + chan; *(f32x4*)cp = (f32x4){xv[0], xv[1], xv[2], xv[3]}; *(f32x4*)(cp + 4) = (f32x4){xv[4], xv[5], xv[6], xv[7]}; } } }
    if (tid < 128) { const int h4 = tid >> 5, row = tid & 31; float dtv = 0.f;
        if (row < nv) dtv = softplus(r.dtr + M.dt_bias()[4 * g + h4]);
        DTs[h4 * 32 + row] = dtv; CUMs[h4 * 32 + row] = -dtv * expf(M.a_log()[4 * g + h4]); }
    if (ci_next >= 0) mambaA_fetch(M, g, ci_next, tid, r);
    lds_barrier();
#pragma unroll 2
    for (int j = 0; j < 4; ++j) { const int row = (tid >> 6) + 8 * j; float o[8];
        { const f32x4 b0 = *(const f32x4*)(CW + 2048 + 8 * seg), b1 = *(const f32x4*)(CW + 2048 + 8 * seg + 4); o[0] = b0[0]; o[1] = b0[1]; o[2] = b0[2]; o[3] = b0[3]; o[4] = b1[0]; o[5] = b1[1]; o[6] = b1[2]; o[7] = b1[3]; }
#pragma unroll
        for (int k = 0; k < 4; ++k) { float xv[8]; unpack8(*(const u32x4*)(RAW + (row + k) * 520 + 8 * seg), xv); const f32x4 w0 = *(const f32x4*)(CW + k * 512 + 8 * seg), w1 = *(const f32x4*)(CW + k * 512 + 8 * seg + 4);
            o[0] += xv[0] * w0[0]; o[1] += xv[1] * w0[1]; o[2] += xv[2] * w0[2]; o[3] += xv[3] * w0[3]; o[4] += xv[4] * w1[0]; o[5] += xv[5] * w1[1]; o[6] += xv[6] * w1[2]; o[7] += xv[7] * w1[3]; }
#pragma unroll
        for (int i = 0; i < 8; ++i) o[i] = row < nv ? silu(o[i]) : 0.f;
        const u32x4 pk = pack8(o);
        if (seg < 32) { *(u32x4*)(Xn + row * 264 + 8 * seg) = pk; if (row < nv) *(u32x4*)(M.XC() + (size_t)(row0 + row) * 1024 + 256 * g + 8 * seg) = pk; }
        else if (seg < 48) { *(u32x4*)(Bn + row * 136 + 8 * (seg - 32)) = pk; if (row < nv) *(u32x4*)(M.BC() + (size_t)(row0 + row) * 512 + 128 * g + 8 * (seg - 32)) = pk; }
        else { *(u32x4*)(Cn + row * 136 + 8 * (seg - 48)) = pk; if (row < nv) *(u32x4*)(M.CC() + (size_t)(row0 + row) * 512 + 128 * g + 8 * (seg - 48)) = pk; }
    }
    if (tid < 4) { float v[32];
#pragma unroll
        for (int t = 0; t < 32; ++t) v[t] = CUMs[tid * 32 + t];
        float a = 0.f;
#pragma unroll
        for (int t = 0; t < 32; ++t) { a += v[t]; CUMs[tid * 32 + t] = a; } }
    lds_barrier();
    if (seg < 32) { const int h4 = seg >> 3;
#pragma unroll
        for (int j = 0; j < 4; ++j) { const int row = (tid >> 6) + 8 * j; const float ww = fexp(CUMs[h4 * 32 + 31] - CUMs[h4 * 32 + row]) * DTs[h4 * 32 + row];
            float xk[8]; unpack8(*(const u32x4*)(Xn + row * 264 + 8 * seg), xk);
#pragma unroll
            for (int i = 0; i < 8; ++i) xk[i] *= ww;
            if (row < nv) *(u32x4*)(M.XW() + (size_t)(row0 + row) * 1024 + 256 * g + 8 * seg) = pack8(xk); } }
    if (tid < 128) M.ECUM()[((size_t)ci * 16 + 4 * g) * 32 + tid] = fexp(CUMs[tid]);
    if (tid < 4) M.MDEC()[(size_t)ci * 16 + 4 * g + tid] = fexp(CUMs[tid * 32 + 31]);
    if (w < 3) { const int tb = w > 0, sb = w > 1; f32x4 P = {0.f, 0.f, 0.f, 0.f};
#pragma unroll
        for (int kk = 0; kk < 4; ++kk) P = mfma16(frag(Bn, 136, 16 * sb + l15, 32 * kk + 8 * quad), frag(Cn, 136, 16 * tb + l15, 32 * kk + 8 * quad), P);
        *(f32x4*)(CBl + (16 * tb + l15) * 36 + 16 * sb + 4 * quad) = P;
    } else if (w == 3) *(f32x4*)(CBl + l15 * 36 + 16 + 4 * quad) = (f32x4){0.f, 0.f, 0.f, 0.f};
    lds_barrier();
    { const int h4 = tid >> 7, t = (tid & 127) >> 2, s0 = 8 * (tid & 3); float wv[8]; const float ct = CUMs[h4 * 32 + t];
#pragma unroll
      for (int i = 0; i < 8; ++i) { const int s = s0 + i; wv[i] = s <= t ? CBl[t * 36 + s] * fexp(ct - CUMs[h4 * 32 + s]) * DTs[h4 * 32 + s] : 0.f; }
      *(u32x4*)(Wl + h4 * 1280 + t * 40 + s0) = pack8(wv); }
    lds_barrier();
    { const int hh = w >> 1, pc0 = 64 * hh + 32 * (w & 1);
#pragma unroll
      for (int pb = 0; pb < 2; ++pb) { const bf16x8 a = trn(Xn, 264, 0, pc0 + 16 * pb, lane);
#pragma unroll
          for (int tb = 0; tb < 2; ++tb) { const int t = 16 * tb + l15; const f32x4 Y = mfma16(a, frag(Wl + hh * 1280, 40, t, 8 * quad), (f32x4){0.f, 0.f, 0.f, 0.f});
              if (t < nv) *(u32x2*)(M.YM() + (size_t)(row0 + t) * 1024 + 256 * g + pc0 + 16 * pb + 4 * quad) = pk4(Y); } } }
    lds_barrier();
}

template <int MODE> DEV void scan_unit(const Mix& M, unsigned char* lds, int b, int hd, int vs) {
    constexpr int KD = MODE == 0 ? 256 : 128, VW = 128, PQ = KD + 8, PK = KD + 16, PV = VW + 16, PO = VW + 8, NKB = KD / 16, NPB = VW / 128, NQ = KD / 128, NV = VW / 128;
    constexpr int SZQ = 32 * PQ * 2, SZK = 32 * PK * 2, SZV = 32 * PV * 2, SZO = 32 * PO * 2, OFF_Q = 0, OFF_K = 2 * SZQ, OFF_V = OFF_K + 2 * SZK, OFF_O = OFF_V + 2 * SZV, OFF_D = OFF_O + SZO;
    const int tid = TID_OPAQUE(), lane = tid & 63, w = uniform(tid >> 6), quad = lane >> 4, l15 = lane & 15;
    float* DECl = (float*)(lds + OFF_D); float* RSl = DECl + 512; bf16_t* OT = (bf16_t*)(lds + OFF_O);
    const bf16_t* gQ = MODE == 0 ? M.PROJ() + C_RQ + 256 * hd : MODE == 1 ? M.PROJ() + C_HQ + 128 * hd : M.CC() + 128 * hd; const int ldQ = MODE == 2 ? 512 : PWP;
    const bf16_t* gK = MODE == 0 ? M.PROJ() + C_RK + 256 * hd : MODE == 1 ? M.PROJ() + C_HF + 128 * hd : M.BC() + 128 * hd; const int ldK = MODE == 2 ? 512 : PWP;
    const bf16_t* gV = MODE == 0 ? M.PROJ() + C_RV + 512 * hd + 128 * vs : MODE == 1 ? M.PROJ() + C_HI + 128 * hd : M.XW() + 256 * hd + 128 * vs; const int ldV = MODE == 2 ? 1024 : PWP;
    bf16_t* gY = MODE == 0 ? M.YR() + 512 * hd + 128 * vs : MODE == 1 ? M.YH() + 128 * hd : M.YM() + 256 * hd + 128 * vs; const int ldY = MODE == 0 ? 2048 : 1024;
    const float lg = log_gamma(hd);
    const int hh = 2 * vs + (w >> 2);
    const int v0 = 16 * w;
    f32x4 S[NPB][NKB];
#pragma unroll
    for (int i = 0; i < NPB; ++i)
#pragma unroll
        for (int j = 0; j < NKB; ++j) S[i][j] = (f32x4){0.f, 0.f, 0.f, 0.f};
    u32x4 rq[NQ], rk[NQ], rv[NV], ro[NV]; f32x4 rd = {0.f, 0.f, 0.f, 0.f};
    const u32x4 zero4 = {0u, 0u, 0u, 0u};
#define SCAN_FETCH(cn) do { int row0_, nv_, pos0_; chunk_geo(b, (cn), row0_, nv_, pos0_); (void)pos0_; const int ci_ = ci_of(b, (cn)); \
        _Pragma("unroll") for (int j = 0; j < NQ; ++j) { const int id = tid + 512 * j, row = id / (KD / 8), sg = id % (KD / 8); const bool ok = row < nv_; \
            rq[j] = ok ? *(const u32x4*)(gQ + (size_t)(row0_ + row) * ldQ + 8 * sg) : zero4; rk[j] = ok ? *(const u32x4*)(gK + (size_t)(row0_ + row) * ldK + 8 * sg) : zero4; } \
        _Pragma("unroll") for (int j = 0; j < NV; ++j) { const int id = tid + 512 * j, row = id / (VW / 8), sg = id % (VW / 8); const bool ok = row < nv_; \
            rv[j] = ok ? *(const u32x4*)(gV + (size_t)(row0_ + row) * ldV + 8 * sg) : zero4; ro[j] = ok ? *(const u32x4*)(gY + (size_t)(row0_ + row) * ldY + 8 * sg) : zero4; } \
        if (MODE == 1) { if (tid < 32) rd = *(const f32x4*)(M.HDEC() + ((size_t)ci_ * 8 + hd) * 128 + 4 * tid); } \
        if (MODE == 2) { if (tid < 32) rd = *(const f32x4*)(M.ECUM() + ((size_t)ci_ * 16 + 4 * hd) * 32 + 4 * tid); else if (tid == 32) rd = *(const f32x4*)(M.MDEC() + (size_t)ci_ * 16 + 4 * hd); } } while (0)
#define SCAN_STORE(d) do { \
        _Pragma("unroll") for (int j = 0; j < NQ; ++j) { const int id = tid + 512 * j, row = id / (KD / 8), sg = id % (KD / 8); \
            *(u32x4*)(lds + OFF_Q + (d) * SZQ + (row * PQ + 8 * sg) * 2) = rq[j]; *(u32x4*)(lds + OFF_K + (d) * SZK + (row * PK + 8 * sg) * 2) = rk[j]; } \
        _Pragma("unroll") for (int j = 0; j < NV; ++j) { const int id = tid + 512 * j, row = id / (VW / 8), sg = id % (VW / 8); \
            *(u32x4*)(lds + OFF_V + (d) * SZV + (row * PV + 8 * sg) * 2) = rv[j]; *(u32x4*)(OT + row * PO + 8 * sg) = ro[j]; } \
        if (MODE == 1) { if (tid < 32) *(f32x4*)(DECl + (d) * 256 + 4 * tid) = rd; } \
        if (MODE == 2) { if (tid < 32) *(f32x4*)(RSl + (d) * 128 + 4 * tid) = rd; else if (tid == 32) *(f32x4*)(DECl + (d) * 256) = rd; } } while (0)
    SCAN_FETCH(0); SCAN_STORE(0);
    block_sync();
    for (int c = 0; c <= NCH; ++c) {
        const int d = c & 1; int row0, nv, pos0; chunk_geo(b, c, row0, nv, pos0); (void)pos0;
        if (c < NCH) SCAN_FETCH(c + 1);
        const bf16_t* Qp = (const bf16_t*)(lds + OFF_Q + d * SZQ); const bf16_t* Kp = (const bf16_t*)(lds + OFF_K + d * SZK); const bf16_t* Vp = (const bf16_t*)(lds + OFF_V + d * SZV);
#pragma unroll
        for (int pb = 0; pb < NPB; ++pb) { const int vc = v0 + 16 * pb;
            f32x4 O0 = {0.f, 0.f, 0.f, 0.f}, O1 = O0;
#pragma unroll
            for (int kk = 0; kk < KD / 32; ++kk) { const bf16x8 sf = pack8v(S[pb][2 * kk], S[pb][2 * kk + 1]);
                O0 = mfma16(sf, fragp(Qp, PQ, l15, 32 * kk, quad), O0); O1 = mfma16(sf, fragp(Qp, PQ, 16 + l15, 32 * kk, quad), O1); }
            if (MODE == 2) { O0 *= RSl[d * 128 + hh * 32 + l15]; O1 *= RSl[d * 128 + hh * 32 + 16 + l15]; }
            { bf16_t* o0 = OT + l15 * PO + vc + 4 * quad; bf16_t* o1 = OT + (16 + l15) * PO + vc + 4 * quad; const u32x2 i0 = *(const u32x2*)o0, i1 = *(const u32x2*)o1;
              O0 += (f32x4){u2f(i0.x << 16), u2f(i0.x & 0xffff0000u), u2f(i0.y << 16), u2f(i0.y & 0xffff0000u)}; O1 += (f32x4){u2f(i1.x << 16), u2f(i1.x & 0xffff0000u), u2f(i1.y << 16), u2f(i1.y & 0xffff0000u)};
              *(u32x2*)o0 = pk4(O0); *(u32x2*)o1 = pk4(O1); }
            const bf16x8 vfn = trn(Vp, PV, 0, vc, lane);
            const float decs = MODE == 0 ? fexp((float)nv * lg) : MODE == 2 ? DECl[d * 256 + hh] : 0.f;
#pragma unroll
            for (int kb = 0; kb < NKB; ++kb) { f32x4 dv = {decs, decs, decs, decs}; if (MODE == 1) dv = *(const f32x4*)(DECl + d * 256 + 16 * kb + 4 * quad);
                S[pb][kb] = mfma16(trn(Kp, PK, 0, 16 * kb, lane), vfn, S[pb][kb] * dv); }
            if (NPB > 1) EPI_FENCE();
        }
        lds_barrier();
        {
            const bool wr = c > 0 || b == 0;
#pragma unroll
            for (int j = 0; j < NV; ++j) { const int id = tid + 512 * j, row = id / (VW / 8), sg = id % (VW / 8); float y[8]; unpack8(*(const u32x4*)(OT + row * PO + 8 * sg), y); float ss = 0.f;
                if (MODE == 2) { float xv[8], zv[8]; const bool ok = row < nv;
                    unpack8(ok ? *(const u32x4*)(M.XC() + (size_t)(row0 + row) * 1024 + 256 * hd + 128 * vs + 8 * sg) : zero4, xv); unpack8(ok ? *(const u32x4*)(M.PROJ() + (size_t)(row0 + row) * PWP + C_Z + 256 * hd + 128 * vs + 8 * sg) : zero4, zv);
                    const float Dh = M.d_skip()[4 * hd + 2 * vs + (sg >> 3)];
#pragma unroll
                    for (int i = 0; i < 8; ++i) y[i] = (y[i] + Dh * xv[i]) * silu(zv[i]); }
#pragma unroll
                for (int i = 0; i < 8; ++i) ss += y[i] * y[i];
                if (MODE != 1 && wr && row < nv) *(u32x4*)(gY + (size_t)(row0 + row) * ldY + 8 * sg) = pack8(y);
#pragma unroll
                for (int o = 1; o < 16; o <<= 1) ss += shflx(ss, o);
                if (MODE == 1) {
                    float gv[8]; unpack8((wr && row < nv) ? *(const u32x4*)(M.PROJ() + (size_t)(row0 + row) * PWP + C_HG + 128 * hd + 8 * sg) : zero4, gv); const float sc = 1.f / sqrtf(ss * (1.f / 128.f) + RMS_EPS);
                    const float* nw = M.in[I_HNW] + M.l * 1024 + 128 * hd + 8 * sg;
#pragma unroll
                    for (int i = 0; i < 8; ++i) y[i] = y[i] * sc * nw[i] * sigm(gv[i]);
                    if (wr && row < nv) *(u32x4*)(gY + (size_t)(row0 + row) * ldY + 8 * sg) = pack8(y); }
                if (wr && row < nv && (tid & 15) == 0) { if (MODE == 0) M.SSQR()[(size_t)(row0 + row) * 16 + 4 * hd + vs] = ss; else if (MODE == 1) M.SSQH()[(size_t)(row0 + row) * 8 + hd] = ss; else M.SSQM()[(size_t)(row0 + row) * 8 + 2 * hd + vs] = ss; }
            }
            if (c < NCH) SCAN_STORE(d ^ 1);
        }
        lds_barrier();
    }
#undef SCAN_FETCH
#undef SCAN_STORE
    if (MODE == 0) { float* so = M.ret_p() + ((size_t)(b * 4 + hd) * 256) * 512 + 128 * vs + v0 + l15;
#pragma unroll
        for (int kb = 0; kb < NKB; ++kb)
#pragma unroll
            for (int e = 0; e < 4; ++e) so[(size_t)(16 * kb + 4 * quad + e) * 512] = S[0][kb][e]; }
    if (MODE == 1) { float* so = M.hgrn_p() + ((size_t)(b * 8 + hd) * 128) * 128 + v0 + l15;
#pragma unroll
        for (int kb = 0; kb < NKB; ++kb)
#pragma unroll
            for (int e = 0; e < 4; ++e) so[(size_t)(16 * kb + 4 * quad + e) * 128] = S[0][kb][e]; }
    if (MODE == 2) {
#pragma unroll
        for (int pb = 0; pb < NPB; ++pb) { float* so = M.ssm_p() + ((size_t)(b * 16 + 4 * hd + hh) * 64 + 16 * (w & 3) + 16 * pb + l15) * 128;
#pragma unroll
            for (int nb = 0; nb < NKB; ++nb) *(f32x4*)(so + 16 * nb + 4 * quad) = S[pb][nb]; } }
    block_sync();
}
DEV float block_sum(float v, float* scr, int tid) {
    v = wave_sum(v); lds_barrier(); if ((tid & 63) == 0) scr[tid >> 6] = v; lds_barrier();
    float s = 0.f;
#pragma unroll
    for (int i = 0; i < 8; ++i) s += scr[i];
    return s;
}
DEV void ret_sample_unit(const Mix& M, unsigned char* lds, int sb, int h) {
    const int tid = TID_OPAQUE(), row = ROW_SMP + sb; const bf16_t* pr = M.PROJ() + (size_t)row * PWP;
    float* qv = (float*)lds; float* kv = qv + 256; float* vv = kv + 256; float* part = vv + 512; float* scr = part + 4 * 512;
    const int v4 = 4 * (tid & 127), r = tid >> 7;
    const float* Sin = M.ret_in() + ((size_t)(sb * 4 + h) * 256) * 512 + v4; float* Sout = M.ret_s() + ((size_t)(sb * 4 + h) * 256) * 512 + v4;
    f32x4 cur[8], nxt[8];
#pragma unroll
    for (int j = 0; j < 8; ++j) cur[j] = ldnt(Sin + (size_t)(4 * j + r) * 512);
    if (tid < 128) { const float* rp = M.rope() + (size_t)(ROPE_ROWS - 1) * 256; const float cs = rp[tid], sn = rp[128 + tid];
        float a1 = bf2f(pr[C_RQ + 256 * h + tid]), a2 = bf2f(pr[C_RQ + 256 * h + 128 + tid]); qv[tid] = a1 * cs - a2 * sn; qv[128 + tid] = a2 * cs + a1 * sn;
        a1 = bf2f(pr[C_RK + 256 * h + tid]); a2 = bf2f(pr[C_RK + 256 * h + 128 + tid]); kv[tid] = (a1 * cs - a2 * sn) * 0.0625f; kv[128 + tid] = (a2 * cs + a1 * sn) * 0.0625f; }
    vv[tid] = bf2f(pr[C_RV + 512 * h + tid]);
    lds_barrier();
    const float gam = expf(log_gamma(h));
    const f32x4 w4 = *(const f32x4*)(vv + v4); f32x4 o = {0.f, 0.f, 0.f, 0.f};
#pragma unroll
    for (int bt = 0; bt < 8; ++bt) {
        if (bt < 7) {
#pragma unroll
            for (int j = 0; j < 8; ++j) nxt[j] = ldnt(Sin + (size_t)(4 * (8 * (bt + 1) + j) + r) * 512); }
#pragma unroll
        for (int j = 0; j < 8; ++j) { const int k = 4 * (8 * bt + j) + r; const f32x4 sn = cur[j] * gam + w4 * kv[k]; stnt(Sout + (size_t)k * 512, sn); o += sn * qv[k]; }
#pragma unroll
        for (int j = 0; j < 8; ++j) cur[j] = nxt[j];
    }
    *(f32x4*)(part + r * 512 + v4) = o;
    lds_barrier();
    const float ov = (part[tid] + part[512 + tid]) + (part[1024 + tid] + part[1536 + tid]);
    M.YR()[(size_t)row * 2048 + 512 * h + tid] = f2bf(ov);
    const float ss = block_sum(ov * ov, scr, tid);
    if (tid < 4) M.SSQR()[(size_t)row * 16 + 4 * h + tid] = tid == 0 ? ss : 0.f;
    lds_barrier();
}
DEV void hgrn_sample_unit(const Mix& M, unsigned char* lds, int sb) {
    const int tid = TID_OPAQUE(), row = ROW_SMP + sb; const bf16_t* pr = M.PROJ() + (size_t)row * PWP;
    float* qv = (float*)lds; float* fv = qv + 1024; float* kv = fv + 1024; float* vv = kv + 1024; float* part = vv + 1024;
    const int v4 = 4 * (tid & 31), r = tid >> 5;
    const float* Sin = M.hgrn_in() + ((size_t)(sb * 8) * 128) * 128 + v4; float* Sout = M.hgrn_s() + ((size_t)(sb * 8) * 128) * 128 + v4;
    f32x4 cur[8], nxt[8];
#pragma unroll
    for (int j = 0; j < 8; ++j) cur[j] = ldnt(Sin + (size_t)(16 * j + r) * 128);
#pragma unroll
    for (int j = 0; j < 2; ++j) { const int c = tid + 512 * j; const float z = bf2f(pr[C_HF + c]), lbv = M.lb()[c]; const float sg = sigm(z);
        qv[c] = bf2f(pr[C_HQ + c]) * 0.08838834764831845f; fv[c] = lbv + (1.f - lbv) * sg; kv[c] = (1.f - lbv) * (1.f - sg); vv[c] = bf2f(pr[C_HI + c]); }
    lds_barrier();
#pragma unroll
    for (int h = 0; h < 8; ++h) {
        if (h < 7) {
#pragma unroll
            for (int j = 0; j < 8; ++j) nxt[j] = ldnt(Sin + (size_t)((h + 1) * 128 + 16 * j + r) * 128); }
        const f32x4 w4 = *(const f32x4*)(vv + 128 * h + v4); f32x4 o = {0.f, 0.f, 0.f, 0.f};
#pragma unroll
        for (int j = 0; j < 8; ++j) { const int k = 16 * j + r; const f32x4 sn = cur[j] * fv[128 * h + k] + w4 * kv[128 * h + k]; stnt(Sout + (size_t)(h * 128 + k) * 128, sn); o += sn * qv[128 * h + k]; }
        *(f32x4*)(part + (h * 16 + r) * 128 + v4) = o;
#pragma unroll
        for (int j = 0; j < 8; ++j) cur[j] = nxt[j];
    }
    lds_barrier();
    {
        const int w = tid >> 6, lane = tid & 63; float a = 0.f, b2 = 0.f;
#pragma unroll
        for (int i = 0; i < 16; ++i) { a += part[(w * 16 + i) * 128 + lane]; b2 += part[(w * 16 + i) * 128 + 64 + lane]; }
        const float ss = wave_sum(a * a + b2 * b2), sc = 1.f / sqrtf(ss * (1.f / 128.f) + RMS_EPS); const float* nw = M.in[I_HNW] + M.l * 1024 + 128 * w;
        M.YH()[(size_t)row * 1024 + 128 * w + lane] = f2bf(a * sc * nw[lane] * sigm(bf2f(pr[C_HG + 128 * w + lane]))); M.YH()[(size_t)row * 1024 + 128 * w + 64 + lane] = f2bf(b2 * sc * nw[64 + lane] * sigm(bf2f(pr[C_HG + 128 * w + 64 + lane])));
    }
    lds_barrier();
}
DEV void mamba_sample_unit(const Mix& M, unsigned char* lds, int sb) {
    const int tid = TID_OPAQUE(), row = ROW_SMP + sb; const bf16_t* pr = M.PROJ() + (size_t)row * PWP;
    float* xbc = (float*)lds; float* dtv = xbc + 2048; float* dav = dtv + 16; float* yv = dav + 16; float* scr = yv + 1024;
    const int n4 = 4 * (tid & 31), r = tid >> 5;
    const float* Sin = M.ssm_in() + ((size_t)(sb * 16) * 64) * 128 + n4; float* Sout = M.ssm_s() + ((size_t)(sb * 16) * 64) * 128 + n4;
    f32x4 cur[8], nxt[8];
#pragma unroll
    for (int j = 0; j < 8; ++j) cur[j] = ldnt(Sin + (size_t)((j >> 2) * 64 + 16 * (j & 3) + r) * 128);
    {
        const int c4 = 4 * tid; const float* cin = M.conv_in() + (size_t)sb * 3 * 2048 + c4; float* cout = M.conv_s() + (size_t)sb * 3 * 2048 + c4;
        const f32x4 r0 = *(const f32x4*)cin, r1 = *(const f32x4*)(cin + 2048), r2 = *(const f32x4*)(cin + 4096);
        f32x4 r3; r3[0] = bf2f(pr[C_X + c4]); r3[1] = bf2f(pr[C_X + c4 + 1]); r3[2] = bf2f(pr[C_X + c4 + 2]); r3[3] = bf2f(pr[C_X + c4 + 3]);
        f32x4 a = *(const f32x4*)(M.conv_b() + c4) + r0 * *(const f32x4*)(M.conv_w() + c4) + r1 * *(const f32x4*)(M.conv_w() + 2048 + c4) + r2 * *(const f32x4*)(M.conv_w() + 4096 + c4) + r3 * *(const f32x4*)(M.conv_w() + 6144 + c4);
#pragma unroll
        for (int i = 0; i < 4; ++i) xbc[c4 + i] = silu(a[i]);
        *(f32x4*)cout = r1; *(f32x4*)(cout + 2048) = r2; *(f32x4*)(cout + 4096) = r3;
    }
    if (tid < 16) { const float d = softplus(M.DT()[(size_t)row * 16 + tid] + M.dt_bias()[tid]); dtv[tid] = d; dav[tid] = expf(-d * expf(M.a_log()[tid])); }
    lds_barrier();
#pragma unroll
    for (int bt = 0; bt < 8; ++bt) {
        if (bt < 7) {
#pragma unroll
            for (int j = 0; j < 8; ++j) nxt[j] = ldnt(Sin + (size_t)((2 * (bt + 1) + (j >> 2)) * 64 + 16 * (j & 3) + r) * 128); }
#pragma unroll
        for (int hq = 0; hq < 2; ++hq) { const int h = 2 * bt + hq; const f32x4 B4 = *(const f32x4*)(xbc + 1024 + 128 * (bt >> 1) + n4), C4 = *(const f32x4*)(xbc + 1536 + 128 * (bt >> 1) + n4); const float da = dav[h], dt = dtv[h];
#pragma unroll
            for (int it = 0; it < 4; ++it) { const int p = 16 * it + r; const f32x4 sn = cur[4 * hq + it] * da + B4 * (dt * xbc[64 * h + p]); stnt(Sout + (size_t)(h * 64 + p) * 128, sn);
                float y = (sn[0] * C4[0] + sn[1] * C4[1]) + (sn[2] * C4[2] + sn[3] * C4[3]);
#pragma unroll
                for (int o = 1; o < 32; o <<= 1) y += shflx(y, o);
                if ((tid & 31) == 0) yv[64 * h + p] = y; } }
#pragma unroll
        for (int j = 0; j < 8; ++j) cur[j] = nxt[j];
    }
    lds_barrier();
#pragma unroll
    for (int j = 0; j < 2; ++j) { const int c = tid + 512 * j; const float y = (yv[c] + M.d_skip()[c >> 6] * xbc[c]) * silu(bf2f(pr[C_Z + c])); M.YM()[(size_t)row * 1024 + c] = f2bf(y);
        const float s = wave_sum(y * y); if ((tid & 63) == 0) scr[(tid >> 6) + 8 * j] = s; }
    lds_barrier();
    if (tid < 4) { const int g = tid; const int j = g >> 1, w0 = 4 * (g & 1); M.SSQM()[(size_t)row * 8 + 2 * g] = (scr[w0 + 8 * j] + scr[w0 + 1 + 8 * j]) + (scr[w0 + 2 + 8 * j] + scr[w0 + 3 + 8 * j]); M.SSQM()[(size_t)row * 8 + 2 * g + 1] = 0.f; }
    lds_barrier();
}

DEV void norm_pass(const Frame& F, const Mix& M, const float* m_norm_w, const float* h_norm_w) {
    const int gw = F.vcu * 8 + F.wave, NGW = F.G * 8, lane = F.lane;
    for (int r = gw; r < R_USED; r += NGW) {
        const bf16_t* pr = M.PROJ() + (size_t)r * PWP;
#pragma unroll
        for (int j = 0; j < 2; ++j) { const int c = 8 * lane + 512 * j; float y[8], g[8];
            unpack8(*(const u32x4*)(M.YM() + (size_t)r * 1024 + c), y); const float sc = 1.f / sqrtf((M.SSQM()[(size_t)r * 8 + 2 * (c >> 8)] + M.SSQM()[(size_t)r * 8 + 2 * (c >> 8) + 1]) * (1.f / 256.f) + RMS_EPS);
#pragma unroll
            for (int i = 0; i < 8; ++i) y[i] = y[i] * sc * m_norm_w[c + i];
            *(u32x4*)(M.YM() + (size_t)r * 1024 + c) = pack8(y);
}
#pragma unroll
        for (int j = 0; j < 4; ++j) { const int c = 8 * lane + 512 * j; float y[8], g[8]; const f32x4 q4 = *(const f32x4*)(M.SSQR() + (size_t)r * 16 + 4 * j);
            unpack8(*(const u32x4*)(M.YR() + (size_t)r * 2048 + c), y); unpack8(*(const u32x4*)(pr + C_RG + c), g); const float sr = 1.f / sqrtf(((q4[0] + q4[1]) + (q4[2] + q4[3])) * (1.f / 512.f) + RMS_EPS);
#pragma unroll
            for (int i = 0; i < 8; ++i) y[i] = y[i] * sr * silu(g[i]);
            *(u32x4*)(M.YR() + (size_t)r * 2048 + c) = pack8(y); }
    }
}

DEV void mixerA_phase(const Frame& F, const Mix& M, int mask = 7) {
    if (mask & 2) { const int u0 = F.vcu; if (u0 < 4 * NCI) { const int g = u0 % 4; MbRaw r; mambaA_cw(M, F.lds, g); mambaA_fetch(M, g, u0 / 4, F.tid, r);
        for (int u = u0; u < 4 * NCI; u += F.G) mambaA_unit(M, F.lds, u % 4, u / 4, r, u + F.G < 4 * NCI ? (u + F.G) / 4 : -1); } }
    if (mask & 1) { const int u0 = F.vcu; if (u0 < 4 * NCI) { RetRaw r; retA_fetch(M, u0 % 4, u0 / 4, F.tid, r);
        for (int u = u0; u < 4 * NCI; u += F.G) retA_unit(M, F.lds, u % 4, u / 4, r, u + F.G < 4 * NCI ? (u + F.G) / 4 : -1); } }
    if (mask & 4) { const int u0 = F.G - 1 - F.vcu; if (u0 < 8 * NCI) { HgRaw r; hgrnA_fetch(M, u0 % 8, u0 / 8, F.tid, r);
        for (int u = u0; u < 8 * NCI; u += F.G) hgrnA_unit(M, F.lds, u % 8, u / 8, r, u + F.G < 8 * NCI ? (u + F.G) / 8 : -1); } }
}
DEV void mixerB_phase(const Frame& F, const Mix& M, unsigned* qhead, int mask = 15) {
    constexpr int NU_R = NB * 16, NU_M = NB * 8, NU_H = NB * 8, NPU = NU_R + NU_M + NU_H, NSU = SB * 6;
    if (F.G * 7 >= NPU * 8) {
        const int nh2 = NU_H / 2;
        for (int u = F.vcu; u < NU_R + NU_M + nh2; u += F.G) {
            if (u < NU_R) { if (mask & 1) scan_unit<0>(M, F.lds, u / 16, (u / 4) % 4, u % 4); }
            else if (u < NU_R + NU_M) { if (mask & 2) scan_unit<2>(M, F.lds, (u - NU_R) / 8, ((u - NU_R) / 2) % 4, (u - NU_R) % 2); }
            else if (mask & 4) { const int v = 2 * (u - NU_R - NU_M); scan_unit<1>(M, F.lds, v / 8, v % 8, 0); scan_unit<1>(M, F.lds, (v + 1) / 8, (v + 1) % 8, 0); }
        }
    } else
    for (int u = F.vcu; u < NPU; u += F.G) {
        if (u < NU_R) { if (mask & 1) scan_unit<0>(M, F.lds, u / 16, (u / 4) % 4, u % 4); }
        else if (u < NU_R + NU_M) { if (mask & 2) scan_unit<2>(M, F.lds, (u - NU_R) / 8, ((u - NU_R) / 2) % 4, (u - NU_R) % 2); }
        else { if (mask & 4) scan_unit<1>(M, F.lds, (u - NU_R - NU_M) / 8, (u - NU_R - NU_M) % 8, 0); }
    }
    if (!(mask & 8)) return;
    unsigned* slot = (unsigned*)(F.lds + 131072 + 64);
    unsigned nx = 0u; if (F.tid == 0) nx = queue_pop(qhead);
    for (;;) {
        if (F.tid == 0) *slot = nx;
        lds_barrier();
        const int u = (int)*slot;
        lds_barrier();
        if (u >= NSU) break;
        if (F.tid == 0) nx = queue_pop(qhead);
        if (u < SB * 4) ret_sample_unit(M, F.lds, u / 4, u % 4);
        else if (u < SB * 5) hgrn_sample_unit(M, F.lds, u - SB * 4);
        else mamba_sample_unit(M, F.lds, u - SB * 5);
    }
}
constexpr int LDS_BYTES = 147456, LDSCTL_OFF = 131072;
constexpr int PPL = 10, N_PHASES = 1 + PPL * DEPTH;
#ifndef MK_N_LAUNCHES
#define MK_N_LAUNCHES 1
#endif
#ifndef REP_G1
#define REP_G1 1
#endif
#ifndef REP_MIX
#define REP_MIX 1
#endif
#ifndef REP_NORM
#define REP_NORM 1
#endif
#ifndef REP_BR
#define REP_BR 1
#endif
#ifndef REP_WO
#define REP_WO 1
#endif
#ifndef REP_LN1
#define REP_LN1 1
#endif
#ifndef REP_FI
#define REP_FI 1
#endif
#ifndef REP_FO
#define REP_FO 1
#endif
#ifndef REP_LN2
#define REP_LN2 1
#endif
#ifndef REP_P0
#define REP_P0 1
#endif
#ifndef REP_MIXB
#define REP_MIXB 1
#endif
#ifndef PROBE_UMASK
#define PROBE_UMASK 7
#endif
#ifndef EMU
#define PROBE_UMASK_EXPR (rep_ == 0 ? 7 : PROBE_UMASK)
#else
#define PROBE_UMASK_EXPR 7
#endif
struct Args { const float* in[28]; float* out; unsigned char* ws; int ph_lo, ph_hi; };

DEV void mix_init(Mix& M, const Frame& P, int l) { M.ws = P.ws; M.out = P.out; M.in = P.in; M.l = l; }
DEV void run_phases(Frame& F, int lo, int hi
#ifndef EMU
    , const XcdBarrier& bar
#endif
) {
#ifndef PHASE_MASK
#define PHASE_MASK 0x7ff
#endif
#define IN(k) (lo <= (k) && (k) < hi)
#define PM(b) ((PHASE_MASK >> (b)) & 1)
#ifndef EMU
#define SEAM(k) do { if (IN(k) && IN((k) + 1)) xcd_barrier(bar); } while (0)
#else
#define SEAM(k) do { } while (0)
#endif
#ifndef EMU
#define PH Frame P = F; { int t_ = F.tid; asm volatile("" : "+v"(t_)); P.tid = t_; P.lane = t_ & 63; P.wave = __builtin_amdgcn_readfirstlane(t_ >> 6); unsigned char* w_ = F.ws; asm volatile("" : "+s"(w_)); P.ws = w_; P.ctl = (unsigned*)(w_ + WS_CTL); \
    const float* const* i_ = F.in; asm volatile("" : "+s"(i_)); P.in = i_; float* o_ = F.out; asm volatile("" : "+s"(o_)); P.out = o_; } unsigned char* const ws = P.ws; (void)ws
#else
#define PH Frame P = F; unsigned char* const ws = P.ws; (void)ws
#endif
#define WSP(T, off) ((T*)(ws + (off)))
#ifndef EMU
#define REPEAT(n) _Pragma("unroll 1") for (int rep_ = 0; rep_ < (n); (void)((++rep_ < (n)) ? (xcd_barrier(bar), 0) : 0))
#else
#define REPEAT(n)
#endif
    if (PM(0) && IN(0)) REPEAT(REP_P0) { PH; p0_prologue(P); } SEAM(0);
    for (int l = 0; l < DEPTH; ++l) {
        const int base = 1 + PPL * l;
        if (PM(1) && IN(base + 0)) REPEAT(REP_G1) {
            PH; pg8::Gemm g{WSP(bf16_t, WS_XN), (const bf16_t*)(ws + WS_W1T + l * SZ_W1T), RP, PW, 1024}; pg8::StaticOrder S; S.init(RP, PW, P.G, BID()); EpiProj E{WSP(bf16_t, WS_PROJ), WSP(float, WS_DT)};
            const bool first = (BID() & 1) != 0;
#pragma unroll 1
            for (int pass = 0; pass < 2; ++pass) {
                if ((pass == 0) == first) { SkProj f{(const bf16_t*)(ws + WS_W1T + l * SZ_W1T), WSP(bf16_t, WS_PROJ), WSP(float, WS_DT)}; skinny_gemm(WSP(bf16_t, WS_XN) + (size_t)RP * 1024, 1024, 257, P.G - 1 - P.vcu, P.G, f, P.lds);
                    dt_gemm(WSP(bf16_t, WS_XN), (const bf16_t*)(ws + WS_W1T + l * SZ_W1T) + (size_t)PW * 1024, WSP(float, WS_DT), P.vcu, P.G); block_sync(); }
                else pg8::gemm_phase<EpiProj, pg8::StaticOrder, false, true>((PG8_LAS unsigned char*)P.lds, g, S, E);
            }
        } SEAM(base + 0);
        if (PM(2) && IN(base + 1)) REPEAT(REP_MIX) { PH; Mix M; mix_init(M, P, l); mixerA_phase(P, M); } SEAM(base + 1);
        if (PM(3) && IN(base + 2)) REPEAT(REP_MIXB) { PH; Mix M; mix_init(M, P, l); mixerB_phase(P, M, P.ctl + CW_QUEUE + 64 * l); } SEAM(base + 2);

        if (PM(4) && IN(base + 3)) REPEAT(REP_NORM) { PH; Mix M; mix_init(M, P, l); norm_pass(P, M, P.in[I_MNW] + l * 1024, P.in[I_HNW] + l * 1024); } SEAM(base + 3);
        if (PM(5) && IN(base + 4)) REPEAT(REP_BR) {
            { PH; pg8::StaticOrder S; S.init(RP, 1024, P.G, BID()); pg8::Gemm g{WSP(bf16_t, WS_YM), (const bf16_t*)(ws + WS_WMT + l * SZ_WSQ), RP, 1024, 1024}; EpiBranch<0> E{WSP(bf16_t, WS_PROJ) + C_GATE, WSP(float, WS_MIX), WSP(bf16_t, WS_MIXB)};
              pg8::gemm_phase<EpiBranch<0>, pg8::StaticOrder, true, true>((PG8_LAS unsigned char*)P.lds, g, S, E);
              SkBranch<0> f{(const bf16_t*)(ws + WS_WMT + l * SZ_WSQ), 1024, WSP(bf16_t, WS_PROJ) + C_GATE, WSP(float, WS_MIX), WSP(bf16_t, WS_MIXB)}; skinny_gemm(WSP(bf16_t, WS_YM) + (size_t)RP * 1024, 1024, 16, P.G - 1 - P.vcu, P.G, f, P.lds); }
            { PH; pg8::StaticOrder S; S.init(RP, 1024, P.G, BID()); pg8::Gemm g{WSP(bf16_t, WS_YH), (const bf16_t*)(ws + WS_WHT + l * SZ_WSQ), RP, 1024, 1024}; EpiBranch<1> E{WSP(bf16_t, WS_PROJ) + C_GATE + 1024, WSP(float, WS_MIX), WSP(bf16_t, WS_MIXB)};
              pg8::gemm_phase<EpiBranch<1>, pg8::StaticOrder, true, true>((PG8_LAS unsigned char*)P.lds, g, S, E);
              SkBranch<1> f{(const bf16_t*)(ws + WS_WHT + l * SZ_WSQ), 1024, WSP(bf16_t, WS_PROJ) + C_GATE + 1024, WSP(float, WS_MIX), WSP(bf16_t, WS_MIXB)}; skinny_gemm(WSP(bf16_t, WS_YH) + (size_t)RP * 1024, 1024, 16, P.G - 1 - P.vcu, P.G, f, P.lds); }
            { PH; pg8::StaticOrder S; S.init(RP, 1024, P.G, BID()); pg8::Gemm g{WSP(bf16_t, WS_YR), (const bf16_t*)(ws + WS_WRT + l * SZ_WRT), RP, 1024, 2048}; EpiBranch<2> E{WSP(bf16_t, WS_PROJ) + C_GATE + 2048, WSP(float, WS_MIX), WSP(bf16_t, WS_MIXB)};
              pg8::gemm_phase<EpiBranch<2>, pg8::StaticOrder, true, true>((PG8_LAS unsigned char*)P.lds, g, S, E);
              SkBranch<2> f{(const bf16_t*)(ws + WS_WRT + l * SZ_WRT), 2048, WSP(bf16_t, WS_PROJ) + C_GATE + 2048, WSP(float, WS_MIX), WSP(bf16_t, WS_MIXB)}; skinny_gemm(WSP(bf16_t, WS_YR) + (size_t)RP * 2048, 2048, 16, P.G - 1 - P.vcu, P.G, f, P.lds); }
        } SEAM(base + 4);
        if (PM(6) && IN(base + 5)) REPEAT(REP_WO) {
            PH; pg8::Gemm g{WSP(bf16_t, WS_MIXB), (const bf16_t*)(ws + WS_WOT + l * SZ_WSQ), RP, 1024, 1024}; pg8::StaticOrder S; S.init(RP, 1024, P.G, BID()); EpiResid E{WSP(bf16_t, WS_XN), WSP(float, WS_XPRE)};
            pg8::gemm_phase<EpiResid, pg8::StaticOrder, true, true>((PG8_LAS unsigned char*)P.lds, g, S, E);
            { SkResid f{(const bf16_t*)(ws + WS_WOT + l * SZ_WSQ), 1024, WSP(bf16_t, WS_XN), WSP(float, WS_XPRE)}; skinny_gemm(WSP(bf16_t, WS_MIXB) + (size_t)RP * 1024, 1024, 16, P.G - 1 - P.vcu, P.G, f, P.lds); }
        } SEAM(base + 5);
        if (PM(7) && IN(base + 6)) REPEAT(REP_LN1) { PH; ln_pass(P, P.in[I_LN1G] + l * 1024, P.in[I_LN1B] + l * 1024, false); } SEAM(base + 6);
        if (PM(8) && IN(base + 7)) REPEAT(REP_FI) {
            PH; pg8::Gemm g{WSP(bf16_t, WS_XN), (const bf16_t*)(ws + WS_WFIT + l * SZ_WFIT), RP, 2 * DFF, 1024}; pg8::StaticOrder S; S.init(RP, 2 * DFF, P.G, BID()); EpiSwiGLU E{WSP(bf16_t, WS_HB)};
            pg8::gemm_phase<EpiSwiGLU, pg8::StaticOrder, true, true>((PG8_LAS unsigned char*)P.lds, g, S, E);
            { SkSwiGLU f{(const bf16_t*)(ws + WS_WFIT + l * SZ_WFIT), WSP(bf16_t, WS_HB)}; skinny_gemm(WSP(bf16_t, WS_XN) + (size_t)RP * 1024, 1024, DFF / 32, P.G - 1 - P.vcu, P.G, f, P.lds); }
        } SEAM(base + 7);
        if (PM(9) && IN(base + 8)) REPEAT(REP_FO) {
            PH; pg8::Gemm g{WSP(bf16_t, WS_HB), (const bf16_t*)(ws + WS_WFOT + l * SZ_WFOT), RP, 1024, DFF}; pg8::StaticOrder S; S.init(RP, 1024, P.G, BID()); EpiResid E{WSP(bf16_t, WS_XN), WSP(float, WS_XPRE)};
            pg8::gemm_phase<EpiResid, pg8::StaticOrder, true, true>((PG8_LAS unsigned char*)P.lds, g, S, E);
            { SkResid f{(const bf16_t*)(ws + WS_WFOT + l * SZ_WFOT), DFF, WSP(bf16_t, WS_XN), WSP(float, WS_XPRE)}; skinny_gemm(WSP(bf16_t, WS_HB) + (size_t)RP * DFF, DFF, 16, P.G - 1 - P.vcu, P.G, f, P.lds); }
        } SEAM(base + 8);
        if (PM(10) && IN(base + 9)) REPEAT(REP_LN2) { PH; ln_pass(P, P.in[I_LN2G] + l * 1024, P.in[I_LN2B] + l * 1024, l == DEPTH - 1); } SEAM(base + 9);
    }
#undef PH
#undef WSP
#undef IN
#undef SEAM
}

#ifndef EMU
__global__ void __launch_bounds__(512, 2) hybrid_fwd(Args args) {
    extern __shared__ __attribute__((aligned(16))) unsigned char lds[];
    Frame F;
    F.lds = lds; F.tid = threadIdx.x; F.lane = F.tid & 63; F.wave = __builtin_amdgcn_readfirstlane(F.tid >> 6);
    F.G = gridDim.x; { const int bx = blockIdx.x; F.vcu = (F.G % 8 == 0) ? (bx % 8) * (F.G / 8) + bx / 8 : bx; }
    F.in = (const float* const*)__builtin_amdgcn_kernarg_segment_ptr();
    F.out = args.out; F.ws = args.ws; F.ctl = (unsigned*)(args.ws + WS_CTL);
    for (int u = F.tid; u < (LDS_BYTES - LDSCTL_OFF) / 4; u += 512) ((unsigned*)(lds + LDSCTL_OFF))[u] = 0u;
    __syncthreads();
    XcdBarrier bar; bar.bar = F.ctl + CW_BAR; bar.x = 0; bar.st = nullptr;
    if (MK_N_LAUNCHES == 1) bar = xcd_barrier_post(F.ctl + CW_BAR, (volatile LAS unsigned*)(lds + LDSCTL_OFF));
    run_phases(F, args.ph_lo, args.ph_hi, bar);
}

extern "C" void kernel_launch(void* const* d_in, const int* in_sizes, int n_in, void* d_out, int out_size, void* d_ws, size_t ws_size, hipStream_t stream) {
    static int grid = 0;
    if (grid == 0) {
        if (n_in != 28 || (size_t)out_size != O_END || ws_size < WS_END) { fprintf(stderr, "kernel_launch: unexpected shapes (n_in %d, out %d, ws %zu; need 28, %zu, >= %zu); nothing launched\n", n_in, out_size, ws_size, (size_t)O_END, (size_t)WS_END); grid = -1; return; }
        int dev = 0, cus = 0, per_cu = 0;
        if (hipGetDevice(&dev) != hipSuccess || hipDeviceGetAttribute(&cus, hipDeviceAttributeMultiprocessorCount, dev) != hipSuccess) { grid = -1; return; }
        if (hipFuncSetAttribute((const void*)hybrid_fwd, hipFuncAttributeMaxDynamicSharedMemorySize, LDS_BYTES) != hipSuccess) { fprintf(stderr, "kernel_launch: hipFuncSetAttribute failed\n"); grid = -1; return; }
        if (hipOccupancyMaxActiveBlocksPerMultiprocessor(&per_cu, (const void*)hybrid_fwd, 512, LDS_BYTES) != hipSuccess || per_cu < 1) fprintf(stderr, "kernel_launch: occupancy query reports %d\n", per_cu);
        (void)hipGetLastError();
        grid = cus;
    }
    if (grid < 0) return;
    if (hipMemsetAsync((char*)d_ws + WS_CTL, 0, CTL_ZERO_BYTES, stream) != hipSuccess) return;
    Args a{};
    for (int i = 0; i < 28; ++i) a.in[i] = (const float*)d_in[i];
    a.out = (float*)d_out; a.ws = (unsigned char*)d_ws;
    if (MK_N_LAUNCHES == 1) { a.ph_lo = 0; a.ph_hi = N_PHASES; hipLaunchKernelGGL(hybrid_fwd, dim3(grid), dim3(512), LDS_BYTES, stream, a); }
    else for (int p = 0; p < N_PHASES; ++p) { a.ph_lo = p; a.ph_hi = p + 1; hipLaunchKernelGGL(hybrid_fwd, dim3(grid), dim3(512), LDS_BYTES, stream, a); }
}
#endif
```
